# Optimizing an MI355X kernel written in HIP

```python
import jax, jax.numpy as jnp
from jax import lax
import numpy as np

D_MODEL = 2048
BATCH = 4
SEQ = 4096
DEPTH = 2

MLA_HEADS = D_MODEL // 256
MLA_NOPE_DIM = 128
MLA_ROPE_DIM = 64
MLA_V_DIM = 128
MLA_QK_DIM = MLA_NOPE_DIM + MLA_ROPE_DIM
MLA_Q_RANK = 3 * D_MODEL // 16
MLA_KV_RANK = D_MODEL // 8
MLA_WIDTH = MLA_HEADS * MLA_V_DIM
HGRN_HEADS = D_MODEL // 256
HGRN_K_DIM = 128
HGRN_V_DIM = 128
HGRN_WIDTH = HGRN_HEADS * HGRN_V_DIM
MIX_WIDTH = MLA_WIDTH + HGRN_WIDTH
IN_WIDTH = MLA_Q_RANK + MLA_KV_RANK + MLA_ROPE_DIM + 2 * HGRN_HEADS * HGRN_K_DIM + 2 * HGRN_WIDTH
CHUNK = 64
ATTN_BLOCK = 128
ROPE_THETA = 10000.0
LB_FLOOR = 1e-30
FFN_DIM = 7 * D_MODEL // 2
N_EXPERTS = 8
TOP_K = 2
N_DENSE = (DEPTH + 1) // 2
N_MOE = DEPTH // 2
PLE_DIM = 256
EPS = 1e-6

kernel_name = 'hybrid_mla_hgrn2_moe_sandwich_ple'


def rms_norm(x, gain):
    xf = x.astype(jnp.float32)
    y = xf * lax.rsqrt(jnp.mean(xf * xf, axis=-1, keepdims=True) + EPS)
    return (y * gain.astype(jnp.float32)).astype(x.dtype)


def rope_tables(positions):
    inv_freq = 1.0 / (ROPE_THETA ** (jnp.arange(0, MLA_ROPE_DIM, 2, dtype=jnp.float32) / MLA_ROPE_DIM))
    ang = positions.astype(jnp.float32)[..., None] * inv_freq
    return jnp.cos(ang), jnp.sin(ang)


def apply_rope(x, cos, sin):
    x1, x2 = jnp.split(x.astype(jnp.float32), 2, axis=-1)
    return jnp.concatenate([x1 * cos - x2 * sin, x2 * cos + x1 * sin], axis=-1).astype(x.dtype)


def mla_group(c_q, c_kv, k_rope, q_norm, kv_norm, w_uq, w_ukv, cos, sin):
    B, S, _ = c_q.shape
    H = MLA_HEADS
    q = (rms_norm(c_q, q_norm) @ w_uq).reshape(B, S, H, MLA_QK_DIM)
    q_nope, q_pe = jnp.split(q, [MLA_NOPE_DIM], axis=-1)
    q_pe = apply_rope(q_pe, cos[:, :, None, :], sin[:, :, None, :])
    kv = (rms_norm(c_kv, kv_norm) @ w_ukv).reshape(B, S, H, MLA_NOPE_DIM + MLA_V_DIM)
    k_nope, v = jnp.split(kv, [MLA_NOPE_DIM], axis=-1)
    k_pe = apply_rope(k_rope, cos, sin)
    q = jnp.concatenate([q_nope, q_pe], axis=-1)
    k = jnp.concatenate([k_nope, jnp.broadcast_to(k_pe[:, :, None, :], (B, S, H, MLA_ROPE_DIM))], axis=-1)
    scale = MLA_QK_DIM ** -0.5
    nb = S // ATTN_BLOCK
    q_blocks = q.reshape(B, nb, ATTN_BLOCK, H, MLA_QK_DIM).transpose(1, 0, 2, 3, 4)
    key_idx = jnp.arange(S)

    def one_block(args):
        q_blk, j = args
        s = jnp.einsum('bqhd,bkhd->bhqk', q_blk, k).astype(jnp.float32) * scale
        q_idx = j * ATTN_BLOCK + jnp.arange(ATTN_BLOCK)
        causal = key_idx[None, :] <= q_idx[:, None]
        s = jnp.where(causal, s, -jnp.inf)
        pr = jax.nn.softmax(s, axis=-1).astype(v.dtype)
        return jnp.einsum('bhqk,bkhv->bqhv', pr, v)

    out = lax.map(one_block, (q_blocks, jnp.arange(nb)))
    return out.transpose(1, 0, 2, 3, 4).reshape(B, S, H * MLA_V_DIM)


def hgrn2_group(q_raw, f_raw, i_raw, g_raw, lb, o_norm):
    B, S, _ = q_raw.shape
    H, K, V = HGRN_HEADS, HGRN_K_DIM, HGRN_V_DIM
    dtype = q_raw.dtype
    q = jax.nn.silu(q_raw.astype(jnp.float32)).reshape(B, S, H, K)
    z = f_raw.astype(jnp.float32).reshape(B, S, H, K)
    lbh = lb.astype(jnp.float32).reshape(H, K)
    log_f = jnp.logaddexp(jnp.log(jnp.maximum(lbh, LB_FLOOR)), jnp.log1p(-lbh) + jax.nn.log_sigmoid(z))
    k = (1.0 - lbh) * jax.nn.sigmoid(-z)
    v = i_raw.astype(jnp.float32).reshape(B, S, H, V)
    N = S // CHUNK

    def to_chunks(t):
        return t.reshape(B, N, CHUNK, H, t.shape[-1]).transpose(1, 0, 3, 2, 4)

    q, k, v, log_f = to_chunks(q), to_chunks(k), to_chunks(v), to_chunks(log_f)
    b = jnp.cumsum(log_f, axis=3)
    causal = jnp.tril(jnp.ones((CHUNK, CHUNK), dtype=bool))[:, :, None]

    def step(state, inp):
        q_c, k_c, v_c, b_c = inp
        diff = b_c[:, :, :, None, :] - b_c[:, :, None, :, :]
        decay = jnp.exp(jnp.where(causal, diff, -jnp.inf))
        a = jnp.einsum('bhtk,bhsk,bhtsk->bhts', q_c, k_c, decay)
        o_intra = jnp.einsum('bhts,bhsv->bhtv', a, v_c)
        o_inter = jnp.einsum('bhtk,bhkv->bhtv', q_c * jnp.exp(b_c), state)
        b_last = b_c[:, :, -1:, :]
        new_state = jnp.exp(b_last[:, :, 0, :])[..., None] * state + \
            jnp.einsum('bhsk,bhsv->bhkv', k_c * jnp.exp(b_last - b_c), v_c)
        return new_state, o_intra + o_inter

    _, o = lax.scan(step, jnp.zeros((B, H, K, V), jnp.float32), (q, k, v, b))
    o = o.transpose(1, 0, 3, 2, 4).reshape(B, S, H, V)
    o = rms_norm(o, o_norm) * jax.nn.silu(g_raw.astype(jnp.float32).reshape(B, S, H, V))
    return o.reshape(B, S, H * V).astype(dtype)


def token_mixer(a, w_in, q_norm, kv_norm, w_uq, w_ukv, lb, o_norm, w_out, cos, sin):
    z = a @ w_in
    hk = HGRN_HEADS * HGRN_K_DIM
    sizes = [MLA_Q_RANK, MLA_KV_RANK, MLA_ROPE_DIM, hk, hk, HGRN_WIDTH]
    offsets = [int(o) for o in np.cumsum(sizes)]
    c_q, c_kv, k_rope, hq, hf, hi, hg = jnp.split(z, offsets, axis=-1)
    y_mla = mla_group(c_q, c_kv, k_rope, q_norm, kv_norm, w_uq, w_ukv, cos, sin)
    y_hgrn = hgrn2_group(hq, hf, hi, hg, lb, o_norm)
    return jnp.concatenate([y_mla, y_hgrn], axis=-1) @ w_out


def swiglu(x, w_gu, w_down):
    g, u = jnp.split(x @ w_gu, 2, axis=-1)
    return (jax.nn.silu(g) * u) @ w_down


def moe_ffn(x, w_router, w_gu, w_down):
    B, S, D = x.shape
    xt = x.reshape(B * S, D)
    logits = (xt @ w_router).astype(jnp.float32)
    top_v, top_i = lax.top_k(logits, TOP_K)
    gates = jax.nn.softmax(top_v, axis=-1)
    combine = jnp.sum(jax.nn.one_hot(top_i, N_EXPERTS, dtype=jnp.float32) * gates[..., None], axis=1).astype(x.dtype)
    y = jnp.zeros_like(xt)
    for e in range(N_EXPERTS):
        y = y + combine[:, e:e + 1] * swiglu(xt, w_gu[e], w_down[e])
    return y.reshape(B, S, D)


def setup_inputs(seed: int = 0) -> dict:
    key = jax.random.key(seed)
    ks = jax.random.split(key, 24)
    f32 = jnp.float32
    hk = HGRN_HEADS * HGRN_K_DIM

    def nrm(k, shape, fan_in):
        return jax.random.normal(k, shape, f32) * (fan_in ** -0.5)

    def gain(k, shape):
        return 1.0 + 0.05 * jax.random.normal(k, shape, f32)

    x = jax.random.normal(ks[0], (BATCH, SEQ, D_MODEL), f32)
    p = jax.random.normal(ks[1], (DEPTH, BATCH, SEQ, PLE_DIM), f32)
    offs = jax.random.randint(ks[2], (BATCH, 1), 0, 1024, dtype=jnp.int32)
    positions = offs + jnp.arange(SEQ, dtype=jnp.int32)[None, :]
    return {
        'x': x,
        'p': p,
        'positions': positions,
        'sandwich_norms': gain(ks[3], (DEPTH, 4, D_MODEL)),
        'w_in': nrm(ks[4], (DEPTH, D_MODEL, IN_WIDTH), D_MODEL),
        'mla_q_norm': gain(ks[5], (DEPTH, MLA_Q_RANK)),
        'mla_kv_norm': gain(ks[6], (DEPTH, MLA_KV_RANK)),
        'w_uq': nrm(ks[7], (DEPTH, MLA_Q_RANK, MLA_HEADS * MLA_QK_DIM), MLA_Q_RANK),
        'w_ukv': nrm(ks[8], (DEPTH, MLA_KV_RANK, MLA_HEADS * (MLA_NOPE_DIM + MLA_V_DIM)), MLA_KV_RANK),
        'hgrn_lb_logits': 0.5 * jax.random.normal(ks[9], (DEPTH, hk), f32),
        'hgrn_out_norm': gain(ks[10], (DEPTH, HGRN_V_DIM)),
        'w_out': nrm(ks[11], (DEPTH, MIX_WIDTH, D_MODEL), MIX_WIDTH),
        'ffn_w_gu': nrm(ks[12], (N_DENSE, D_MODEL, 2 * FFN_DIM), D_MODEL),
        'ffn_w_down': nrm(ks[13], (N_DENSE, FFN_DIM, D_MODEL), FFN_DIM),
        'moe_w_router': nrm(ks[14], (N_MOE, D_MODEL, N_EXPERTS), D_MODEL),
        'moe_w_gu': nrm(ks[15], (N_MOE, N_EXPERTS, D_MODEL, 2 * FFN_DIM), D_MODEL),
        'moe_w_down': nrm(ks[16], (N_MOE, N_EXPERTS, FFN_DIM, D_MODEL), FFN_DIM),
        'ple_w_proj': nrm(ks[17], (DEPTH, PLE_DIM, D_MODEL), PLE_DIM),
        'ple_w_gate': nrm(ks[18], (DEPTH, D_MODEL, D_MODEL), D_MODEL),
        'ple_norm': gain(ks[19], (DEPTH, D_MODEL)),
    }


def reference(x, p, positions, sandwich_norms, w_in, mla_q_norm, mla_kv_norm, w_uq, w_ukv,
              hgrn_lb_logits, hgrn_out_norm, w_out, ffn_w_gu, ffn_w_down, moe_w_router,
              moe_w_gu, moe_w_down, ple_w_proj, ple_w_gate, ple_norm):
    cos, sin = rope_tables(positions)
    pr = jax.nn.softmax(hgrn_lb_logits.astype(jnp.float32), axis=0)
    lower_bounds = jnp.cumsum(pr, axis=0) - pr[0:1]
    h = x
    for l in range(DEPTH):
        a = rms_norm(h, sandwich_norms[l, 0])
        y = token_mixer(a, w_in[l], mla_q_norm[l], mla_kv_norm[l], w_uq[l], w_ukv[l],
                        lower_bounds[l], hgrn_out_norm[l], w_out[l], cos, sin)
        h = h + rms_norm(y, sandwich_norms[l, 1])
        c = rms_norm(h, sandwich_norms[l, 2])
        if l % 2 == 0:
            f = swiglu(c, ffn_w_gu[l // 2], ffn_w_down[l // 2])
        else:
            f = moe_ffn(c, moe_w_router[l // 2], moe_w_gu[l // 2], moe_w_down[l // 2])
        h = h + rms_norm(f, sandwich_norms[l, 3])
        gate = jax.nn.sigmoid((h @ ple_w_gate[l]).astype(jnp.float32)).astype(h.dtype)
        h = h + rms_norm(gate * (p[l] @ ple_w_proj[l]), ple_norm[l])
    return h
```

```cpp
#include <hip/hip_runtime.h>
#include <cstdio>
#include <cstdint>
#ifndef MK_ONE_LAUNCH
#define MK_ONE_LAUNCH 1
#endif
__device__ __forceinline__ int hw_lane() { int l; asm volatile("v_mbcnt_lo_u32_b32 %0, -1, 0\n\tv_mbcnt_hi_u32_b32 %0, -1, %0" : "=v"(l)); return l; }
namespace pg8 {
#define PG8_LAS __attribute__((address_space(3)))
typedef unsigned short bf16_t;
typedef short bf16x8 __attribute__((ext_vector_type(8)));
typedef float f32x4 __attribute__((ext_vector_type(4)));
typedef unsigned u32x4 __attribute__((ext_vector_type(4)));
constexpr int BM = 256, BK = 64, HALF = 128, HTB = HALF * BK * 2  , STAGE_BYTES = 8 * HTB, NXCD = 8, WGM = 8;

__host__ __device__ __forceinline__ int lds_byte(int r, int c) { const int st = (r >> 4) * 2 + (c >> 5), rr = r & 15, cc = c & 31, ob = rr * 64 + cc * 2; return st * 1024 + (ob ^ (((ob >> 9) & 1) << 5)); }
__host__ __device__ __forceinline__ void stage_rc(int b, int& R, int& C) { const int st = b / 1024, sb = b % 1024, swz = sb ^ (((sb >> 9) & 1) << 5); R = (st >> 1) * 16 + swz / 64; C = (st & 1) * 32 + (swz % 64) / 2; }
__host__ __device__ __forceinline__ int perm32(int rho) { const int n = rho >> 4, i = rho & 15; return 8 * (i >> 2) + 4 * n + (i & 3); }

struct Unit { int pm, pn; };
struct Gemm { const bf16_t* A; const bf16_t* Bt; int M, N, K; };

struct StaticOrder {
    int nM, nN, nwg, G, c;
    __host__ __device__ void init(int M, int N, int G_, int c_) { nM = M / BM; nN = N / BM; nwg = nM * nN; G = G_; c = c_; }
    __host__ __device__ bool next(int i, Unit& u) const {
        const long L = (long)i * G + c; if (L >= nwg) return false;
        int wgid = (int)L; { const int q = nwg / NXCD, r = nwg % NXCD, xcd = wgid % NXCD, off = wgid / NXCD; wgid = (xcd < r ? xcd * (q + 1) : r * (q + 1) + (xcd - r) * q) + off; }
        const int nig = WGM * nN, gid = wgid / nig, fm = gid * WGM, gsz = (nM - fm) < WGM ? (nM - fm) : WGM;
        u.pm = fm + ((wgid % nig) % gsz); u.pn = (wgid % nig) / gsz; return true;
    }
    __device__ __forceinline__ void a_ready(const Unit&) const {}
    __device__ __forceinline__ void done(const Unit&) const {}
};

__device__ __forceinline__ unsigned cvt_pk_bf16(float lo, float hi) { unsigned r; asm volatile("v_cvt_pk_bf16_f32 %0, %1, %2" : "=v"(r) : "v"(lo), "v"(hi)); return r; }
typedef float f32x2 __attribute__((ext_vector_type(2)));

template <class Epi, class Sched, bool ALIGN_EPI = false, bool SP2 = false>
__device__ __forceinline__ void gemm_phase(PG8_LAS unsigned char* lds, const Gemm g, const Sched& S, const Epi& E, const int wid) {
    const int lane = hw_lane(), tid = wid * 64 + lane, wr = wid >> 2, wc = wid & 3, fr = lane & 15, fq = lane >> 4;
    const int K = g.K, nt = K / BK;
    unsigned voffA[2], voffB[2];
#pragma unroll
    for (int i = 0; i < 2; ++i) { int R, C; stage_rc(tid * 16 + i * 8192, R, C); const int Rb = Epi::PERM ? ((R & ~31) + perm32(R & 31)) : R;
        voffA[i] = (unsigned)(R * K + C) * 2u; voffB[i] = (unsigned)(Rb * K + C) * 2u; }
    const size_t kstep = (size_t)(BK * 2);
    const size_t hstep = (size_t)HALF * K * 2;
    const size_t tstep = 2 * hstep;
    const unsigned ldsw = (unsigned)wid * 1024u;
    const int aoff = lds_byte(wr * 64 + fr, fq * 8), boff = lds_byte(wc * 32 + fr, fq * 8);
#define PG8_SA(b, h) (((b) * 2 + (h)) * HTB)
#define PG8_SB(b, h) ((4 + (b) * 2 + (h)) * HTB)
#define PG8_STAGE(bufoff, gbase, voff) do { _Pragma("unroll") for (int _i = 0; _i < 2; ++_i) \
        __builtin_amdgcn_global_load_lds((const unsigned*)((const char*)(gbase) + (voff)[_i]), (PG8_LAS unsigned*)(lds + (bufoff) + ldsw + _i * 8192), 16, 0, 0); } while (0)
#define PG8_LDA(dst, b, h) do { _Pragma("unroll") for (int m = 0; m < 4; ++m) _Pragma("unroll") for (int k = 0; k < 2; ++k) dst[m][k] = *(const PG8_LAS bf16x8*)(lds + PG8_SA(b, h) + aoff + m * 2048 + k * 1024); } while (0)
#define PG8_LDB(dst, b, h) do { _Pragma("unroll") for (int n = 0; n < 2; ++n) _Pragma("unroll") for (int k = 0; k < 2; ++k) dst[n][k] = *(const PG8_LAS bf16x8*)(lds + PG8_SB(b, h) + boff + n * 2048 + k * 1024); } while (0)
#define PG8_MMA(ai, bj, At, Bt) do { __builtin_amdgcn_s_setprio(1); _Pragma("unroll") for (int m = 0; m < 4; ++m) _Pragma("unroll") for (int n = 0; n < 2; ++n) _Pragma("unroll") for (int k = 0; k < 2; ++k) \
        acc[ai][bj][m][n] = __builtin_amdgcn_mfma_f32_16x16x32_bf16(Bt[n][k], At[m][k], acc[ai][bj][m][n], 0, 0, 0); __builtin_amdgcn_s_setprio(0); } while (0)
#define PG8_WAIT_V(n) asm volatile("s_waitcnt vmcnt(" #n ")" ::: "memory")
#define PG8_WAIT_L(n) asm volatile("s_waitcnt lgkmcnt(" #n ")" ::: "memory")
#define PG8_BAR __builtin_amdgcn_s_barrier()
#define PG8_SCHED __builtin_amdgcn_sched_barrier(0)
    Unit cur, nxt; int ui = 0;
    if (!S.next(0, cur)) return;
    f32x4 acc[2][2][4][2];
#pragma unroll
    for (int a = 0; a < 2; ++a)
#pragma unroll
        for (int b = 0; b < 2; ++b)
#pragma unroll
            for (int m = 0; m < 4; ++m)
#pragma unroll
                for (int n = 0; n < 2; ++n) acc[a][b][m][n] = (f32x4){0.f, 0.f, 0.f, 0.f};
    bf16x8 At[4][2], B0[2][2], B1[2][2];
    const char* cA = (const char*)g.A + (size_t)cur.pm * tstep; const char* cB = (const char*)g.Bt + (size_t)cur.pn * tstep;
    S.a_ready(cur);
    if constexpr (SP2) {
        PG8_STAGE(PG8_SB(0, 0), cB, voffB); PG8_STAGE(PG8_SB(0, 1), cB + hstep, voffB); PG8_STAGE(PG8_SA(0, 0), cA, voffA); PG8_STAGE(PG8_SA(0, 1), cA + hstep, voffA);
        if (wr == 1) PG8_BAR;
        PG8_WAIT_V(2); PG8_BAR;
        PG8_STAGE(PG8_SB(1, 0), cB + kstep, voffB); PG8_STAGE(PG8_SA(1, 0), cA + kstep, voffA); PG8_STAGE(PG8_SB(1, 1), cB + hstep + kstep, voffB);
        PG8_WAIT_V(6); PG8_BAR;
    } else {
        PG8_STAGE(PG8_SB(0, 0), cB, voffB); PG8_STAGE(PG8_SA(0, 0), cA, voffA); PG8_STAGE(PG8_SB(0, 1), cB + hstep, voffB); PG8_STAGE(PG8_SA(0, 1), cA + hstep, voffA);
        if (wr == 1) PG8_BAR;
        PG8_WAIT_V(4); PG8_BAR;
        PG8_STAGE(PG8_SB(1, 0), cB + kstep, voffB); PG8_STAGE(PG8_SA(1, 0), cA + kstep, voffA); PG8_STAGE(PG8_SB(1, 1), cB + hstep + kstep, voffB);
        PG8_WAIT_V(6); PG8_BAR;
    }
    for (;;) {
        const bool has_next = S.next(ui + 1, nxt);
        const char* nA = has_next ? (const char*)g.A + (size_t)nxt.pm * tstep : cA; const char* nB = has_next ? (const char*)g.Bt + (size_t)nxt.pn * tstep : cB;
        for (int t = 0; t < nt; t += 2) {
            const bool last = (t == nt - 2);
            const char* a1 = cA + (size_t)(t + 1) * kstep;
            const char* a2 = last ? nA : cA + (size_t)(t + 2) * kstep; const char* b2 = last ? nB : cB + (size_t)(t + 2) * kstep;
            const char* a3 = a2 + kstep; const char* b3 = b2 + kstep;
            if (last && has_next) S.a_ready(nxt);
            if constexpr (SP2) {
            PG8_LDB(B0, 0, 0); PG8_LDB(B1, 0, 1); PG8_SCHED; PG8_LDA(At, 0, 0); PG8_STAGE(PG8_SA(1, 1), a1 + hstep, voffA);
            PG8_WAIT_V(8); PG8_WAIT_L(0); PG8_BAR; PG8_MMA(0, 0, At, B0); PG8_MMA(0, 1, At, B1); PG8_BAR; PG8_SCHED;
            PG8_LDA(At, 0, 1); PG8_STAGE(PG8_SB(0, 0), b2, voffB); PG8_STAGE(PG8_SB(0, 1), b2 + hstep, voffB); PG8_STAGE(PG8_SA(0, 0), a2, voffA);
            PG8_WAIT_V(8); PG8_WAIT_L(0); PG8_BAR; PG8_MMA(1, 0, At, B0); PG8_MMA(1, 1, At, B1); PG8_BAR; PG8_SCHED;
            PG8_LDB(B0, 1, 0); PG8_LDB(B1, 1, 1); PG8_SCHED; PG8_LDA(At, 1, 0); PG8_STAGE(PG8_SA(0, 1), a2 + hstep, voffA);
            PG8_WAIT_V(8); PG8_WAIT_L(0); PG8_BAR; PG8_MMA(0, 0, At, B0); PG8_MMA(0, 1, At, B1); PG8_BAR; PG8_SCHED;
            PG8_LDA(At, 1, 1); PG8_STAGE(PG8_SB(1, 0), b3, voffB); PG8_STAGE(PG8_SB(1, 1), b3 + hstep, voffB); PG8_STAGE(PG8_SA(1, 0), a3, voffA);
            PG8_WAIT_V(8); PG8_WAIT_L(0); PG8_BAR; PG8_MMA(1, 0, At, B0); PG8_MMA(1, 1, At, B1); PG8_BAR; PG8_SCHED;
            } else {
            PG8_LDB(B0, 0, 0); PG8_SCHED; PG8_LDA(At, 0, 0); PG8_STAGE(PG8_SA(1, 1), a1 + hstep, voffA);
            PG8_WAIT_L(8); PG8_BAR; PG8_WAIT_L(0); PG8_MMA(0, 0, At, B0); PG8_BAR; PG8_SCHED;
            PG8_LDB(B1, 0, 1); PG8_STAGE(PG8_SB(0, 0), b2, voffB);
            PG8_BAR; PG8_WAIT_L(0); PG8_MMA(0, 1, At, B1); PG8_BAR;
            PG8_LDA(At, 0, 1); PG8_STAGE(PG8_SA(0, 0), a2, voffA);
            PG8_BAR; PG8_WAIT_L(0); PG8_MMA(1, 0, At, B0); PG8_BAR; PG8_SCHED;
            PG8_STAGE(PG8_SB(0, 1), b2 + hstep, voffB);
            PG8_WAIT_V(6); PG8_BAR; PG8_MMA(1, 1, At, B1); PG8_BAR;
            PG8_LDB(B0, 1, 0); PG8_SCHED; PG8_LDA(At, 1, 0); PG8_STAGE(PG8_SA(0, 1), a2 + hstep, voffA);
            PG8_WAIT_L(8); PG8_BAR; PG8_WAIT_L(0); PG8_MMA(0, 0, At, B0); PG8_BAR; PG8_SCHED;
            PG8_LDB(B1, 1, 1); PG8_STAGE(PG8_SB(1, 0), b3, voffB);
            PG8_BAR; PG8_WAIT_L(0); PG8_MMA(0, 1, At, B1); PG8_BAR;
            PG8_LDA(At, 1, 1); PG8_STAGE(PG8_SA(1, 0), a3, voffA);
            PG8_BAR; PG8_WAIT_L(0); PG8_MMA(1, 0, At, B0); PG8_BAR; PG8_SCHED;
            PG8_STAGE(PG8_SB(1, 1), b3 + hstep, voffB);
            PG8_WAIT_V(6); PG8_BAR; PG8_MMA(1, 1, At, B1); PG8_BAR;
            }
        }
        if constexpr (ALIGN_EPI) { if (wr == 0) PG8_BAR; }
        if constexpr (!Epi::AFTER_DRAIN) { const int l2 = hw_lane(); E(acc, cur, wr, wc, l2 & 15, l2 >> 4); S.done(cur); }
        if (!has_next) break;
#pragma unroll
        for (int a = 0; a < 2; ++a)
#pragma unroll
            for (int b = 0; b < 2; ++b)
#pragma unroll
                for (int m = 0; m < 4; ++m)
#pragma unroll
                    for (int n = 0; n < 2; ++n) acc[a][b][m][n] = (f32x4){0.f, 0.f, 0.f, 0.f};
        cur = nxt; cA = nA; cB = nB; ++ui;
        if constexpr (ALIGN_EPI) { if (wr == 1) PG8_BAR; }
    }
    PG8_WAIT_V(0);
    if constexpr (!ALIGN_EPI) { if (wr == 0) PG8_BAR; }
    PG8_BAR;
    if constexpr (Epi::AFTER_DRAIN) { E.fused(acc, cur, wr, wc, fr, fq, lds, wid, lane); S.done(cur); }
#undef PG8_SA
#undef PG8_SB
#undef PG8_STAGE
#undef PG8_LDA
#undef PG8_LDB
#undef PG8_MMA
#undef PG8_WAIT_V
#undef PG8_WAIT_L
#undef PG8_BAR
#undef PG8_SCHED
}
}
#define GAS __attribute__((address_space(1)))
#define LAS __attribute__((address_space(3)))
typedef unsigned short bf16;
typedef unsigned v4u __attribute__((ext_vector_type(4)));
typedef float f32x4 __attribute__((ext_vector_type(4)));
typedef short bf16x8 __attribute__((ext_vector_type(8)));
typedef GAS unsigned gu32;
typedef GAS unsigned long long gu64;
#define RLX_AGENT __ATOMIC_RELAXED, __HIP_MEMORY_SCOPE_AGENT
#define LDS_WAIT() asm volatile("s_waitcnt lgkmcnt(0)" ::: "memory")
#define VM_WAIT() asm volatile("s_waitcnt vmcnt(0)" ::: "memory")
__device__ __forceinline__ unsigned long long rt() { return __builtin_amdgcn_s_memrealtime(); }
__device__ __forceinline__ unsigned f2bf(float f) { unsigned u = __builtin_bit_cast(unsigned, f); return (u + 0x7fffu + ((u >> 16) & 1u)) >> 16; }
__device__ __forceinline__ unsigned pk2(float lo, float hi) { return f2bf(lo) | (f2bf(hi) << 16); }

#define XB_TMO      128
#define XB_XCNT(j)  (256  + 64 * (j))
#define XB_XSUB(j)  (1280 + 64 * (j))
#define XB_XGEN(j)  (2304 + 64 * (j))
#define XB_TOP      3328
#define XB_TOPGEN   3392
#define XCD_BAR_WORDS 3456
#define XB_SPIN_CAP (1u << 18)

__device__ __forceinline__ unsigned xb_ld(unsigned* p)              { return __hip_atomic_load(p, __ATOMIC_RELAXED, __HIP_MEMORY_SCOPE_AGENT); }
__device__ __forceinline__ unsigned xb_add(unsigned* p, unsigned v) { return __hip_atomic_fetch_add(p, v, __ATOMIC_RELAXED, __HIP_MEMORY_SCOPE_AGENT); }
__device__ __forceinline__ unsigned xb_xcc_id() { return (unsigned)__builtin_amdgcn_s_getreg((3 << 11) | 20) & 0xFu; }
#define XB_SPIN(cond, bar) do { unsigned _sp = 0; while (cond) { __builtin_amdgcn_s_sleep(1); \
    if ((++_sp & 255u) == 0u) { if (xb_ld(&(bar)[XB_TMO])) break; if (_sp > XB_SPIN_CAP) { atomicAdd(&(bar)[XB_TMO], 1u); break; } } } } while (0)

struct XcdBarrier {
    unsigned* bar; unsigned x;
    int w;
    volatile LAS unsigned* st;
};

__device__ __forceinline__ XcdBarrier xcd_barrier_post(unsigned* bar, volatile LAS unsigned* st) {
    XcdBarrier b; b.bar = bar; b.x = xb_xcc_id(); b.st = st; b.w = __builtin_amdgcn_readfirstlane((int)threadIdx.x >> 6);
    if (threadIdx.x == 0) (void)xb_add(&bar[XB_XCNT(b.x)], 1u);
    return b;
}
__device__ __forceinline__ void xcd_barrier_complete(unsigned* bar, unsigned x, unsigned& nloc, unsigned& nx) {
    const unsigned G = gridDim.x * gridDim.y * gridDim.z;
    unsigned sum, cnt, mine, sp = 0u;
    for (;;) {
        sum = 0u; cnt = 0u; mine = 0u;
#pragma unroll
        for (unsigned j = 0; j < 16; ++j) { const unsigned c = xb_ld(&bar[XB_XCNT(j)]); sum += c; cnt += (c > 0u) ? 1u : 0u; mine = (j == x) ? c : mine; }
        if (sum == G) break;
        __builtin_amdgcn_s_sleep(1);
        if ((++sp & 255u) == 0u) { if (xb_ld(&bar[XB_TMO])) break; if (sp > XB_SPIN_CAP) { atomicAdd(&bar[XB_TMO], 1u); break; } }
    }
    nloc = mine > 0u ? mine : 1u; nx = cnt > 0u ? cnt : 1u;
}

__device__ __forceinline__ void xcd_barrier(const XcdBarrier& b) {
    asm volatile("s_waitcnt vmcnt(0)" ::: "memory");
    __syncthreads();
    if (b.w == 0 && hw_lane() == 0) {
        unsigned* bar = b.bar;
        __builtin_amdgcn_s_waitcnt(0);
        unsigned nloc = b.st[0], nx = b.st[1];
        if (nloc == 0u) { xcd_barrier_complete(bar, b.x, nloc, nx); b.st[0] = nloc; b.st[1] = nx; }
        const unsigned old = xb_add(&bar[XB_XSUB(b.x)], 1u);
        const unsigned gen = old / nloc;
        if (old + 1u == (gen + 1u) * nloc) {
            __builtin_amdgcn_fence(__ATOMIC_RELEASE, "agent");
            asm volatile("s_waitcnt vmcnt(0)" ::: "memory");
            const unsigned og = xb_add(&bar[XB_TOP], 1u);
            const unsigned tg = og / nx;
            if (og + 1u == (tg + 1u) * nx) xb_add(&bar[XB_TOPGEN], 1u);
            else XB_SPIN(xb_ld(&bar[XB_TOPGEN]) == tg, bar);
            __builtin_amdgcn_fence(__ATOMIC_ACQUIRE, "agent");
            xb_add(&bar[XB_XGEN(b.x)], 1u);
            asm volatile("s_waitcnt vmcnt(0)" ::: "memory");
        } else {
            XB_SPIN(xb_ld(&bar[XB_XGEN(b.x)]) == gen, bar);
            __builtin_amdgcn_fence(__ATOMIC_ACQUIRE, "agent");
            asm volatile("s_waitcnt vmcnt(0)" ::: "memory");
        }
    }
    __syncthreads();
}

namespace pg8 {
struct EpiBf16P {
    static constexpr bool PERM = true, AFTER_DRAIN = false;
    bf16_t* O; int ldc;
    __device__ __forceinline__ void operator()(const f32x4 (&acc)[2][2][4][2], const Unit& u, int wr, int wc, int fr, int fq) const {
        const int row0 = u.pm * BM + wr * 64 + fr, col0 = u.pn * BM + wc * 32 + 8 * fq;
#pragma unroll
        for (int ai = 0; ai < 2; ++ai)
#pragma unroll
            for (int m = 0; m < 4; ++m) { bf16_t* rowp = O + (size_t)(row0 + ai * HALF + m * 16) * ldc + col0;
#pragma unroll
                for (int bj = 0; bj < 2; ++bj) { const f32x4 v0 = acc[ai][bj][m][0], v1 = acc[ai][bj][m][1];
                    u32x4 w; w.x = cvt_pk_bf16(v0[0], v0[1]); w.y = cvt_pk_bf16(v0[2], v0[3]); w.z = cvt_pk_bf16(v1[0], v1[1]); w.w = cvt_pk_bf16(v1[2], v1[3]);
                    *(u32x4*)(rowp + bj * HALF) = w; } }
    }
};
struct EpiQRope {
    static constexpr bool PERM = true, AFTER_DRAIN = false;
    bf16_t* O; int ldc; const float* cosT; const float* sinT; float scale;
    __device__ __forceinline__ void operator()(const f32x4 (&acc)[2][2][4][2], const Unit& u, int wr, int wc, int fr, int fq) const {
        const int row0 = u.pm * BM + wr * 64 + fr, col0 = u.pn * BM + wc * 32 + 8 * fq;
#pragma unroll
        for (int ai = 0; ai < 2; ++ai)
#pragma unroll
            for (int m = 0; m < 4; ++m) { const int row = row0 + ai * HALF + m * 16; bf16_t* rowp = O + (size_t)row * ldc + col0;
#pragma unroll
                for (int bj = 0; bj < 2; ++bj) { f32x4 v0 = acc[ai][bj][m][0], v1 = acc[ai][bj][m][1];
                    const int hc = (col0 + bj * HALF) % 192;
                    if (hc >= 128) { const int i0 = (hc - 128) >> 1;
                        const f32x4 c4 = *(const f32x4*)(cosT + (size_t)row * 32 + i0), s4 = *(const f32x4*)(sinT + (size_t)row * 32 + i0);
                        f32x4 r0, r1;
                        r0[0] = v0[0] * c4[0] - v0[1] * s4[0]; r0[1] = v0[1] * c4[0] + v0[0] * s4[0];
                        r0[2] = v0[2] * c4[1] - v0[3] * s4[1]; r0[3] = v0[3] * c4[1] + v0[2] * s4[1];
                        r1[0] = v1[0] * c4[2] - v1[1] * s4[2]; r1[1] = v1[1] * c4[2] + v1[0] * s4[2];
                        r1[2] = v1[2] * c4[3] - v1[3] * s4[3]; r1[3] = v1[3] * c4[3] + v1[2] * s4[3];
                        v0 = r0; v1 = r1; }
                    v0 = v0 * scale; v1 = v1 * scale;
                    u32x4 w; w.x = cvt_pk_bf16(v0[0], v0[1]); w.y = cvt_pk_bf16(v0[2], v0[3]); w.z = cvt_pk_bf16(v1[0], v1[1]); w.w = cvt_pk_bf16(v1[2], v1[3]);
                    *(u32x4*)(rowp + bj * HALF) = w; } }
    }
};
struct EpiF32P {
    static constexpr bool PERM = false, AFTER_DRAIN = false;
    float* C; int ldc;
    __device__ __forceinline__ void operator()(const f32x4 (&acc)[2][2][4][2], const Unit& u, int wr, int wc, int fr, int fq) const {
        const int row0 = u.pm * BM + wr * 64 + fr, col0 = u.pn * BM + wc * 32 + 4 * fq;
#pragma unroll
        for (int ai = 0; ai < 2; ++ai)
#pragma unroll
            for (int m = 0; m < 4; ++m) { float* rowp = C + (size_t)(row0 + ai * HALF + m * 16) * ldc + col0;
#pragma unroll
                for (int bj = 0; bj < 2; ++bj)
#pragma unroll
                    for (int n = 0; n < 2; ++n) *(f32x4*)(rowp + bj * HALF + n * 16) = acc[ai][bj][m][n]; }
    }
};
struct EpiSwiGLU {
    static constexpr bool PERM = false, AFTER_DRAIN = false;
    bf16_t* H; int ldh; int npn;
    __device__ __forceinline__ void operator()(const f32x4 (&acc)[2][2][4][2], const Unit& u, int wr, int wc, int fr, int fq) const {
        const int row0 = u.pm * BM + wr * 64 + fr, j0 = (u.pn % npn) * 128 + wc * 16 + 4 * fq;
#pragma unroll
        for (int ai = 0; ai < 2; ++ai)
#pragma unroll
            for (int m = 0; m < 4; ++m) { bf16_t* rowp = H + (size_t)(row0 + ai * HALF + m * 16) * ldh + j0;
#pragma unroll
                for (int bj = 0; bj < 2; ++bj) { const f32x4 g = acc[ai][bj][m][0], uu = acc[ai][bj][m][1]; f32x4 h;
#pragma unroll
                    for (int i = 0; i < 4; ++i) h[i] = g[i] * __builtin_amdgcn_rcpf(1.0f + __builtin_amdgcn_exp2f(-1.4426950408889634f * g[i])) * uu[i];
                    typedef unsigned u32x2v __attribute__((ext_vector_type(2)));
                    u32x2v w; w.x = cvt_pk_bf16(h[0], h[1]); w.y = cvt_pk_bf16(h[2], h[3]);
                    *(u32x2v*)(rowp + bj * 64) = w; } }
    }
};
struct EpiPleGate {
    static constexpr bool PERM = false, AFTER_DRAIN = false;
    float* R; const float* P; int ldc;
    __device__ __forceinline__ void operator()(const f32x4 (&acc)[2][2][4][2], const Unit& u, int wr, int wc, int fr, int fq) const {
        const int row0 = u.pm * BM + wr * 64 + fr, col0 = u.pn * BM + wc * 32 + 4 * fq;
#pragma unroll
        for (int ai = 0; ai < 2; ++ai)
#pragma unroll
            for (int m = 0; m < 4; ++m) { const size_t off = (size_t)(row0 + ai * HALF + m * 16) * ldc + col0;
#pragma unroll
                for (int bj = 0; bj < 2; ++bj)
#pragma unroll
                    for (int n = 0; n < 2; ++n) { const f32x4 a = acc[ai][bj][m][n], p = *(const f32x4*)(P + off + bj * HALF + n * 16); f32x4 r;
#pragma unroll
                        for (int i = 0; i < 4; ++i) r[i] = p[i] * __builtin_amdgcn_rcpf(1.0f + __builtin_amdgcn_exp2f(-1.4426950408889634f * a[i]));
                        *(f32x4*)(R + off + bj * HALF + n * 16) = r; } }
    }
};
}

constexpr int T = 16384, DM = 2048, SEQ = 4096, NBATCH = 4, DEPTH = 2;
constexpr int ZW = 4864, ZREAL = 4800;
constexpr int CQ0 = 0, CKV0 = 384, KR0 = 640, HQ0 = 704, HF0 = 1728, HI0 = 2752, HG0 = 3776;
constexpr int QRANK = 384, KVRANK = 256, NH = 8, DQK = 192, QW = 1536, KVW = 2048;
constexpr int FF = 7168, GU = 14336, NE = 8, PLE = 256;
constexpr float EPS = 1e-6f;
constexpr float QSCALE = 0.07216878364870322f * 1.4426950408889634f;
constexpr int NWAVES = 8;
constexpr int LDS_BYTES = 147456;
constexpr int RING_BYTES = 131072;
constexpr int MISC_OFF = RING_BYTES + 320;

constexpr size_t MiB = 1ull << 20;
constexpr size_t rup(size_t x) { return (x + MiB - 1) & ~(MiB - 1); }
constexpr size_t WS_CTL = 0, CTL_ZERO_BYTES = 1 * MiB;
constexpr size_t WS_LB   = 1 * MiB;
constexpr size_t WS_COS  = 2 * MiB;
constexpr size_t WS_SIN  = 4 * MiB;
constexpr size_t WS_SELE = 6 * MiB;
constexpr size_t WS_SELG = 7 * MiB;
constexpr size_t WS_WIN  = 8 * MiB;
constexpr size_t WS_WUQ  = WS_WIN  + rup(2ull * ZW * DM * 2);
constexpr size_t WS_WUKV = WS_WUQ  + rup(2ull * QW * QRANK * 2);
constexpr size_t WS_WOUT = WS_WUKV + rup(2ull * KVW * KVRANK * 2);
constexpr size_t WS_WGU  = WS_WOUT + rup(2ull * DM * DM * 2);
constexpr size_t WS_WDN  = WS_WGU  + rup(1ull * GU * DM * 2);
constexpr size_t WS_MGU  = WS_WDN  + rup(1ull * DM * FF * 2);
constexpr size_t WS_MDN  = WS_MGU  + rup(8ull * GU * DM * 2);
constexpr size_t WS_WPP  = WS_MDN  + rup(8ull * DM * FF * 2);
constexpr size_t WS_WPG  = WS_WPP  + rup(2ull * DM * PLE * 2);
constexpr size_t WS_XN   = WS_WPG  + rup(2ull * DM * DM * 2);
constexpr size_t WS_Z    = WS_XN   + rup(1ull * T * DM * 2);
constexpr size_t WS_CQ   = WS_Z    + rup(1ull * T * ZW * 2);
constexpr size_t WS_CKV  = WS_CQ   + rup(1ull * T * QRANK * 2);
constexpr size_t WS_KPE  = WS_CKV  + rup(1ull * T * KVRANK * 2);
constexpr size_t WS_Q    = WS_KPE  + rup(1ull * T * 64 * 2);
constexpr size_t WS_KV   = WS_Q    + rup(1ull * T * QW * 2);
constexpr size_t WS_Y    = WS_KV   + rup(1ull * T * KVW * 2);
constexpr size_t WS_YO   = WS_Y    + rup(1ull * T * DM * 2);
constexpr size_t WS_PP   = WS_YO   + rup(1ull * T * DM * 4);
constexpr size_t WS_PB   = WS_PP   + rup(1ull * T * DM * 4);
constexpr size_t WS_FB   = WS_PB   + rup(2ull * T * PLE * 2);
constexpr size_t WS_HB   = WS_FB   + rup(1ull * T * DM * 4);
constexpr size_t WS_END  = WS_HB   + rup(1ull * 34816 * FF * 2);

constexpr int CW_BAR = 4096;

__device__ __forceinline__ float bflo(unsigned w) { return __builtin_bit_cast(float, w << 16); }
__device__ __forceinline__ float bfhi(unsigned w) { return __builtin_bit_cast(float, w & 0xffff0000u); }
__device__ __forceinline__ float bf2f(bf16 b) { return __builtin_bit_cast(float, ((unsigned)b) << 16); }
__device__ __forceinline__ float wave_sum(float v) {
#pragma unroll
    for (int o = 1; o < 64; o <<= 1) v += __shfl_xor(v, o);
    return v;
}
__device__ __forceinline__ float wave_max(float v) {
#pragma unroll
    for (int o = 1; o < 64; o <<= 1) v = fmaxf(v, __shfl_xor(v, o));
    return v;
}
__device__ __forceinline__ float sigmoidf_(float x) { return 1.0f / (1.0f + __expf(-x)); }
__device__ __forceinline__ float siluf_(float x) { return x / (1.0f + __expf(-x)); }

struct MapId { __device__ __forceinline__ int operator()(int n) const { return n; } };
struct MapIn { __device__ __forceinline__ int operator()(int n) const { if (n < KR0 || n >= KR0 + 64) return n; const int i = n - KR0; return KR0 + (i < 32 ? 2 * i : 2 * (i - 32) + 1); } };
struct MapUq { __device__ __forceinline__ int operator()(int n) const { const int h = n / DQK, d = n - h * DQK; if (d < 128) return n; const int i = d - 128; return h * DQK + 128 + (i < 32 ? 2 * i : 2 * (i - 32) + 1); } };
struct MapGu { __device__ __forceinline__ int operator()(int n) const { const int isu = n >= FF ? 1 : 0, j = n - isu * FF; return 32 * (j >> 4) + 16 * isu + (j & 15); } };

template <class Map>
__device__ __forceinline__ void cvt_item(const float* W, int K, int N, bf16* WT, Map map, LAS float* scr, int item, int lane) {
    const int nblk = N / 32, kb = item / nblk, nb = item - kb * nblk, k0 = 64 * kb, n0 = 32 * nb;
    const int kr = lane >> 3, c4 = lane & 7;
#pragma unroll
    for (int i = 0; i < 8; ++i) {
        const f32x4 v = *(const GAS f32x4*)(W + (size_t)(k0 + 8 * i + kr) * N + n0 + 4 * c4);
        LAS float* s = scr + (8 * i + kr) * 33 + 4 * c4;
        s[0] = v.x; s[1] = v.y; s[2] = v.z; s[3] = v.w;
    }
    LDS_WAIT(); asm volatile("" ::: "memory");
#pragma unroll
    for (int j = 0; j < 4; ++j) {
        const int n = (lane >> 3) + 8 * j;
        const LAS float* s = scr + (8 * c4) * 33 + n;
        v4u o; o.x = pk2(s[0], s[33]); o.y = pk2(s[66], s[99]); o.z = pk2(s[132], s[165]); o.w = pk2(s[198], s[231]);
        *(GAS v4u*)(WT + (size_t)map(n0 + n) * K + k0 + 8 * c4) = o;
    }
    LDS_WAIT(); asm volatile("" ::: "memory");
}
template <class Map>
__device__ __forceinline__ void cvt_matrix(const float* W, int K, int N, bf16* WT, Map map, int& cum, int gw, int NGW, LAS float* scr, int lane) {
    const int nitems = (K / 64) * (N / 32);
    const int first = (gw - (cum % NGW) + NGW) % NGW;
    for (int it = first; it < nitems; it += NGW) cvt_item(W, K, N, WT, map, scr, it, lane);
    cum += nitems;
}

__device__ __forceinline__ void row_load(const float* row, int lane, f32x4 (&v)[8]) {
#pragma unroll
    for (int j = 0; j < 8; ++j) v[j] = ((const GAS f32x4*)row)[lane + 64 * j];
}
__device__ __forceinline__ void row_store(float* row, int lane, const f32x4 (&v)[8]) {
#pragma unroll
    for (int j = 0; j < 8; ++j) ((GAS f32x4*)row)[lane + 64 * j] = v[j];
}
__device__ __forceinline__ float row_ss(const f32x4 (&v)[8]) {
    float s = 0.f;
#pragma unroll
    for (int j = 0; j < 8; ++j) s += (v[j].x * v[j].x + v[j].y * v[j].y) + (v[j].z * v[j].z + v[j].w * v[j].w);
    return wave_sum(s);
}
__device__ __forceinline__ void row_store_bf16(bf16* row, int lane, const f32x4 (&v)[8]) {
    typedef unsigned u32x2v __attribute__((ext_vector_type(2)));
#pragma unroll
    for (int j = 0; j < 8; ++j) { u32x2v w; w.x = pk2(v[j].x, v[j].y); w.y = pk2(v[j].z, v[j].w); ((GAS u32x2v*)row)[lane + 64 * j] = w; }
}

struct Args { const float* in[20]; float* out; unsigned char* ws; int ph_lo, ph_hi; };

constexpr int NPL = 33;
constexpr int NPH = 1 + DEPTH * NPL;

#define CAS __attribute__((address_space(4)))
typedef const float* cfp_t;
#define KARG_IN(k) (*(const cfp_t CAS*)(ka + 8 * (k)))
__device__ __forceinline__ int launder_v(int v) { asm volatile("" : "+v"(v)); return v; }
__device__ __forceinline__ const CAS unsigned char* launder_ka() { const CAS unsigned char* p = (const CAS unsigned char*)__builtin_amdgcn_kernarg_segment_ptr(); asm volatile("" : "+s"(p)); return p; }
#define PHASE_BEGIN const int lane = hw_lane(), tid = wave * 64 + lane; const CAS unsigned char* ka = launder_ka(); unsigned char* const wsl = *(unsigned char* const CAS*)(ka + 168); \
    const int gw = bid * NWAVES + wave, NGW = G * NWAVES; (void)tid; (void)lane; (void)ka; (void)wsl; (void)gw; (void)NGW;
#define I_x          (KARG_IN(0))
#define I_pin        (KARG_IN(1))
#define I_positions  ((const int*)KARG_IN(2))
#define I_snorm      (KARG_IN(3))
#define I_w_in       (KARG_IN(4))
#define I_qnorm      (KARG_IN(5))
#define I_kvnorm     (KARG_IN(6))
#define I_w_uq       (KARG_IN(7))
#define I_w_ukv      (KARG_IN(8))
#define I_lbl        (KARG_IN(9))
#define I_onorm      (KARG_IN(10))
#define I_w_out      (KARG_IN(11))
#define I_f_gu       (KARG_IN(12))
#define I_f_dn       (KARG_IN(13))
#define I_m_rt       (KARG_IN(14))
#define I_m_gu       (KARG_IN(15))
#define I_m_dn       (KARG_IN(16))
#define I_p_wp       (KARG_IN(17))
#define I_p_wg       (KARG_IN(18))
#define I_p_nm       (KARG_IN(19))
#define I_out        (*(float* const CAS*)(ka + 160))
#define W_LB   ((float*)(wsl + WS_LB))
#define W_COS  ((float*)(wsl + WS_COS))
#define W_SIN  ((float*)(wsl + WS_SIN))
#define W_SELE ((int*)(wsl + WS_SELE))
#define W_SELG ((float*)(wsl + WS_SELG))
#define W_WIN  ((bf16*)(wsl + WS_WIN))
#define W_WUQ  ((bf16*)(wsl + WS_WUQ))
#define W_WUKV ((bf16*)(wsl + WS_WUKV))
#define W_WOUT ((bf16*)(wsl + WS_WOUT))
#define W_WGU  ((bf16*)(wsl + WS_WGU))
#define W_WDN  ((bf16*)(wsl + WS_WDN))
#define W_MGU  ((bf16*)(wsl + WS_MGU))
#define W_MDN  ((bf16*)(wsl + WS_MDN))
#define W_WPP  ((bf16*)(wsl + WS_WPP))
#define W_WPG  ((bf16*)(wsl + WS_WPG))
#define W_XN   ((bf16*)(wsl + WS_XN))
#define W_Z    ((bf16*)(wsl + WS_Z))
#define W_CQ   ((bf16*)(wsl + WS_CQ))
#define W_CKV  ((bf16*)(wsl + WS_CKV))
#define W_KPE  ((bf16*)(wsl + WS_KPE))
#define W_Q    ((bf16*)(wsl + WS_Q))
#define W_KV   ((bf16*)(wsl + WS_KV))
#define W_Y    ((bf16*)(wsl + WS_Y))
#define W_YO   ((float*)(wsl + WS_YO))
#define W_PP   ((float*)(wsl + WS_PP))
#define W_PB   ((bf16*)(wsl + WS_PB))
#define W_FB   ((float*)(wsl + WS_FB))
#define W_HB   ((bf16*)(wsl + WS_HB))

#define PH(k) (lo <= (k) && (k) < hi)
#define SEAM(k) do { if (lo <= (k) && (k) + 1 < hi) xcd_barrier(bar); } while (0)

template <int l>
__device__ __forceinline__ void layer_phases(const int lo, const int hi, const XcdBarrier& bar, LAS unsigned char* lds, const int wave, const int G, const int bid) {
        const int base = 1 + l * NPL;
#define SN_L (I_snorm + (size_t)l * 4 * DM)
        if (PH(base + 0)) { PHASE_BEGIN
            pg8::Gemm g{W_XN, W_WIN + (size_t)l * ZW * DM, T, ZW, DM}; pg8::StaticOrder S; S.init(T, ZW, G, bid);
            pg8::EpiBf16P E{W_Z, ZW};
            pg8::gemm_phase<pg8::EpiBf16P, pg8::StaticOrder, true, true>(lds, g, S, E, wave);
        }
        SEAM(base + 0);
        if (PH(base + 1)) { PHASE_BEGIN
            const float* qn = I_qnorm + (size_t)l * QRANK; const float* kn = I_kvnorm + (size_t)l * KVRANK;
            for (int m = gw; m < T; m += NGW) {
                const bf16* zr = W_Z + (size_t)m * ZW;
                unsigned a[3]; float ss = 0.f;
#pragma unroll
                for (int j = 0; j < 3; ++j) { a[j] = *(const GAS unsigned*)(zr + CQ0 + 2 * lane + 128 * j); const float lo_ = bflo(a[j]), hi_ = bfhi(a[j]); ss += lo_ * lo_ + hi_ * hi_; }
                float rstd = rsqrtf(wave_sum(ss) * (1.0f / QRANK) + EPS);
#pragma unroll
                for (int j = 0; j < 3; ++j) { const int c = 2 * lane + 128 * j; *(GAS unsigned*)(W_CQ + (size_t)m * QRANK + c) = pk2(bflo(a[j]) * rstd * qn[c], bfhi(a[j]) * rstd * qn[c + 1]); }
                unsigned b2[2]; ss = 0.f;
#pragma unroll
                for (int j = 0; j < 2; ++j) { b2[j] = *(const GAS unsigned*)(zr + CKV0 + 2 * lane + 128 * j); const float lo_ = bflo(b2[j]), hi_ = bfhi(b2[j]); ss += lo_ * lo_ + hi_ * hi_; }
                rstd = rsqrtf(wave_sum(ss) * (1.0f / KVRANK) + EPS);
#pragma unroll
                for (int j = 0; j < 2; ++j) { const int c = 2 * lane + 128 * j; *(GAS unsigned*)(W_CKV + (size_t)m * KVRANK + c) = pk2(bflo(b2[j]) * rstd * kn[c], bfhi(b2[j]) * rstd * kn[c + 1]); }
                if (lane < 32) { const unsigned w = *(const GAS unsigned*)(zr + KR0 + 2 * lane); const float x1 = bflo(w), x2 = bfhi(w), c = W_COS[(size_t)m * 32 + lane], s = W_SIN[(size_t)m * 32 + lane];
                    *(GAS unsigned*)(W_KPE + (size_t)m * 64 + 2 * lane) = pk2(x1 * c - x2 * s, x2 * c + x1 * s); }
            }
        }
        SEAM(base + 1);
        if (PH(base + 2)) { PHASE_BEGIN
            { pg8::Gemm g{W_CQ, W_WUQ + (size_t)l * QW * QRANK, T, QW, QRANK}; pg8::StaticOrder S; S.init(T, QW, G, bid);
              pg8::EpiQRope E{W_Q, QW, W_COS, W_SIN, QSCALE};
              pg8::gemm_phase<pg8::EpiQRope, pg8::StaticOrder, true, true>(lds, g, S, E, wave); }
            { pg8::Gemm g{W_CKV, W_WUKV + (size_t)l * KVW * KVRANK, T, KVW, KVRANK}; pg8::StaticOrder S; S.init(T, KVW, G, bid);
              pg8::EpiBf16P E{W_KV, KVW};
              pg8::gemm_phase<pg8::EpiBf16P, pg8::StaticOrder, true, true>(lds, g, S, E, wave); }
            { pg8::Gemm g{W_PB + (size_t)l * T * PLE, W_WPP + (size_t)l * DM * PLE, T, DM, PLE}; pg8::StaticOrder S; S.init(T, DM, G, bid);
              pg8::EpiF32P E{W_PP, DM};
              pg8::gemm_phase<pg8::EpiF32P, pg8::StaticOrder, true, true>(lds, g, S, E, wave); }
        }
        SEAM(base + 2);
        if (PH(base + 3)) { PHASE_BEGIN
            for (int u = bid; u < NBATCH * NH; u += G) {
                const int b = u / NH, h = u % NH;
                LAS float* qs = (LAS float*)lds; LAS float* fs = qs + 2048; LAS float* ks = fs + 2048; LAS float* vs = ks + 2048; LAS float* red = vs + 2048; LAS float* og = red + 8192;
                const int v = tid & 127, kq = tid >> 7, k0 = 32 * kq;
                float S[32];
#pragma unroll
                for (int i = 0; i < 32; ++i) S[i] = 0.f;
                const float* lbp = W_LB + (size_t)l * 1024 + h * 128;
                for (int c16 = 0; c16 < SEQ / 16; ++c16) {
                    for (int idx = tid; idx < 2048; idx += 512) {
                        const int t = idx >> 7, ch = idx & 127; const bf16* zr = W_Z + ((size_t)b * SEQ + c16 * 16 + t) * ZW + h * 128 + ch;
                        const float qr = bf2f(zr[HQ0]), fr = bf2f(zr[HF0]), ir = bf2f(zr[HI0]), lbv = lbp[ch];
                        qs[idx] = siluf_(qr); fs[idx] = lbv + (1.0f - lbv) * sigmoidf_(fr); ks[idx] = (1.0f - lbv) * sigmoidf_(-fr); vs[idx] = ir;
                    }
                    __syncthreads();
                    for (int t = 0; t < 16; ++t) {
                        const float vt = vs[t * 128 + v]; float po = 0.f;
#pragma unroll
                        for (int i = 0; i < 32; ++i) { S[i] = fs[t * 128 + k0 + i] * S[i] + ks[t * 128 + k0 + i] * vt; po += S[i] * qs[t * 128 + k0 + i]; }
                        red[(t * 4 + kq) * 128 + v] = po;
                    }
                    __syncthreads();
                    for (int idx = tid; idx < 2048; idx += 512) { const int t = idx >> 7, ch = idx & 127; og[idx] = (red[(t * 4 + 0) * 128 + ch] + red[(t * 4 + 1) * 128 + ch]) + (red[(t * 4 + 2) * 128 + ch] + red[(t * 4 + 3) * 128 + ch]); }
                    __syncthreads();
                    for (int t = wave; t < 16; t += 8) {
                        const float x0 = og[t * 128 + lane], x1 = og[t * 128 + 64 + lane];
                        const float rstd = rsqrtf(wave_sum(x0 * x0 + x1 * x1) * (1.0f / 128.0f) + EPS);
                        const size_t tok = (size_t)b * SEQ + c16 * 16 + t; const bf16* zr = W_Z + tok * ZW + HG0 + h * 128;
                        const float g0 = bf2f(zr[lane]), g1 = bf2f(zr[64 + lane]);
                        const float* on = I_onorm + (size_t)l * 128;
                        W_Y[tok * DM + 1024 + h * 128 + lane] = (bf16)f2bf(x0 * rstd * on[lane] * siluf_(g0));
                        W_Y[tok * DM + 1024 + h * 128 + 64 + lane] = (bf16)f2bf(x1 * rstd * on[64 + lane] * siluf_(g1));
                    }
                    __syncthreads();
                }
            }
            {
                LAS float* qs = (LAS float*)lds + wave * 192;
                for (int u = bid; u < NBATCH * NH * (SEQ / 8); u += G) {
                    const int s8 = u % (SEQ / 8), bh = u / (SEQ / 8), h = bh % NH, b = bh / NH;
                    const int s = s8 * 8 + wave; const size_t tq = (size_t)b * SEQ + s;
                    const bf16* qrow = W_Q + tq * QW + h * DQK;
#pragma unroll
                    for (int j = 0; j < 3; ++j) qs[lane + 64 * j] = bf2f(qrow[lane + 64 * j]);
                    LDS_WAIT(); asm volatile("" ::: "memory");
                    float mrun = -1e30f, lrun = 0.f, o0 = 0.f, o1 = 0.f;
                    for (int kb = 0; kb <= s; kb += 64) {
                        const int j = kb + lane; const bool valid = j <= s;
                        float sc = -__builtin_inff();
                        if (valid) {
                            const size_t tk = (size_t)b * SEQ + j; const bf16* kn = W_KV + tk * KVW + h * 256; const bf16* kp = W_KPE + tk * 64;
                            float acc = 0.f;
                            for (int d8 = 0; d8 < 16; ++d8) { const v4u w = *(const GAS v4u*)(kn + 8 * d8); const f32x4 qa = *(const LAS f32x4*)(qs + 8 * d8), qb = *(const LAS f32x4*)(qs + 8 * d8 + 4);
                                acc += qa.x * bflo(w.x) + qa.y * bfhi(w.x) + qa.z * bflo(w.y) + qa.w * bfhi(w.y) + qb.x * bflo(w.z) + qb.y * bfhi(w.z) + qb.z * bflo(w.w) + qb.w * bfhi(w.w); }
                            for (int d8 = 0; d8 < 8; ++d8) { const v4u w = *(const GAS v4u*)(kp + 8 * d8); const f32x4 qa = *(const LAS f32x4*)(qs + 128 + 8 * d8), qb = *(const LAS f32x4*)(qs + 128 + 8 * d8 + 4);
                                acc += qa.x * bflo(w.x) + qa.y * bfhi(w.x) + qa.z * bflo(w.y) + qa.w * bfhi(w.y) + qb.x * bflo(w.z) + qb.y * bfhi(w.z) + qb.z * bflo(w.w) + qb.w * bfhi(w.w); }
                            sc = acc;
                        }
                        const float mn = fmaxf(mrun, wave_max(sc)), alpha = exp2f(mrun - mn), p = valid ? exp2f(sc - mn) : 0.f;
                        lrun = lrun * alpha + wave_sum(p); o0 *= alpha; o1 *= alpha; mrun = mn;
                        const int cnt = (s - kb + 1) < 64 ? (s - kb + 1) : 64;
                        for (int jj = 0; jj < cnt; ++jj) { const float pj = __shfl(p, jj); const unsigned w = *(const GAS unsigned*)(W_KV + ((size_t)b * SEQ + kb + jj) * KVW + h * 256 + 128 + 2 * lane); o0 += pj * bflo(w); o1 += pj * bfhi(w); }
                    }
                    const float rl = 1.0f / lrun;
                    *(GAS unsigned*)(W_Y + tq * DM + h * 128 + 2 * lane) = pk2(o0 * rl, o1 * rl);
                    asm volatile("" ::: "memory");
                }
            }
        }
        SEAM(base + 3);
        if (PH(base + 4)) { PHASE_BEGIN
            pg8::Gemm g{W_Y, W_WOUT + (size_t)l * DM * DM, T, DM, DM}; pg8::StaticOrder S; S.init(T, DM, G, bid);
            pg8::EpiF32P E{W_YO, DM};
            pg8::gemm_phase<pg8::EpiF32P, pg8::StaticOrder, true, true>(lds, g, S, E, wave);
        }
        SEAM(base + 4);
        if (PH(base + 5)) { PHASE_BEGIN
            const float* hin = (l == 0) ? I_x : I_out;
            const float* wr = I_m_rt + (size_t)(l / 2) * DM * NE;
            for (int m = gw; m < T; m += NGW) {
                f32x4 y[8], hh[8], g[8]; row_load(W_YO + (size_t)m * DM, lane, y); row_load(hin + (size_t)m * DM, lane, hh); row_load(SN_L + DM, lane, g);
                float rstd = rsqrtf(row_ss(y) * (1.0f / DM) + EPS);
#pragma unroll
                for (int j = 0; j < 8; ++j) hh[j] = hh[j] + y[j] * rstd * g[j];
                row_store(I_out + (size_t)m * DM, lane, hh);
                row_load(SN_L + 2 * DM, lane, g);
                rstd = rsqrtf(row_ss(hh) * (1.0f / DM) + EPS);
#pragma unroll
                for (int j = 0; j < 8; ++j) hh[j] = hh[j] * rstd * g[j];
                row_store_bf16(W_XN + (size_t)m * DM, lane, hh);
                if (l & 1) {
                    float lg[8];
#pragma unroll
                    for (int e = 0; e < 8; ++e) lg[e] = 0.f;
#pragma unroll
                    for (int j = 0; j < 8; ++j)
#pragma unroll
                        for (int i = 0; i < 4; ++i) { const int k = 256 * j + 4 * lane + i; const f32x4 w0 = *(const GAS f32x4*)(wr + (size_t)k * 8), w1 = *(const GAS f32x4*)(wr + (size_t)k * 8 + 4); const float c = hh[j][i];
                            lg[0] += c * w0.x; lg[1] += c * w0.y; lg[2] += c * w0.z; lg[3] += c * w0.w; lg[4] += c * w1.x; lg[5] += c * w1.y; lg[6] += c * w1.z; lg[7] += c * w1.w; }
#pragma unroll
                    for (int e = 0; e < 8; ++e) lg[e] = wave_sum(lg[e]);
                    int e0 = 0; float v0 = lg[0];
#pragma unroll
                    for (int e = 1; e < 8; ++e) if (lg[e] > v0) { v0 = lg[e]; e0 = e; }
                    int e1 = -1; float v1 = -__builtin_inff();
#pragma unroll
                    for (int e = 0; e < 8; ++e) if (e != e0 && lg[e] > v1) { v1 = lg[e]; e1 = e; }
                    const float ex = __expf(v1 - v0), g0 = 1.0f / (1.0f + ex), g1 = ex / (1.0f + ex);
                    if (lane == 0) { W_SELE[m] = e0 | (e1 << 8); W_SELG[2 * m] = g0; W_SELG[2 * m + 1] = g1; }
                }
            }
        }
        SEAM(base + 5);
        if ((l & 1) == 0) {
            if (PH(base + 6)) { PHASE_BEGIN
                pg8::Gemm g{W_XN, W_WGU, T, GU, DM}; pg8::StaticOrder S; S.init(T, GU, G, bid);
                pg8::EpiSwiGLU E{W_HB, FF, GU / 256};
                pg8::gemm_phase<pg8::EpiSwiGLU, pg8::StaticOrder, true, true>(lds, g, S, E, wave);
            }
            SEAM(base + 6);
            if (PH(base + 7)) { PHASE_BEGIN
                pg8::Gemm g{W_HB, W_WDN, T, DM, FF}; pg8::StaticOrder S; S.init(T, DM, G, bid);
                pg8::EpiF32P E{W_YO, DM};
                pg8::gemm_phase<pg8::EpiF32P, pg8::StaticOrder, true, true>(lds, g, S, E, wave);
            }
            SEAM(base + 7);
        } else {
            for (int e = 0; e < NE; ++e) {
                const int k = base + 6 + 3 * e;
                if (PH(k)) { PHASE_BEGIN
                    pg8::Gemm g{W_XN, W_MGU + (size_t)e * GU * DM, T, GU, DM}; pg8::StaticOrder S; S.init(T, GU, G, bid);
                    pg8::EpiSwiGLU E{W_HB, FF, GU / 256};
                    pg8::gemm_phase<pg8::EpiSwiGLU, pg8::StaticOrder, true, true>(lds, g, S, E, wave);
                }
                SEAM(k);
                if (PH(k + 1)) { PHASE_BEGIN
                    pg8::Gemm g{W_HB, W_MDN + (size_t)e * DM * FF, T, DM, FF}; pg8::StaticOrder S; S.init(T, DM, G, bid);
                    pg8::EpiF32P E{W_YO, DM};
                    pg8::gemm_phase<pg8::EpiF32P, pg8::StaticOrder, true, true>(lds, g, S, E, wave);
                }
                SEAM(k + 1);
                if (PH(k + 2)) { PHASE_BEGIN
                    for (int m = gw; m < T; m += NGW) {
                        const int se = W_SELE[m]; const float w = ((se & 255) == e) ? W_SELG[2 * m] : (((se >> 8) & 255) == e ? W_SELG[2 * m + 1] : 0.f);
                        f32x4 y[8], f[8]; row_load(W_YO + (size_t)m * DM, lane, y);
                        if (e == 0) {
#pragma unroll
                            for (int j = 0; j < 8; ++j) f[j] = y[j] * w;
                        } else { row_load(W_FB + (size_t)m * DM, lane, f);
#pragma unroll
                            for (int j = 0; j < 8; ++j) f[j] = f[j] + y[j] * w; }
                        row_store(W_FB + (size_t)m * DM, lane, f);
                    }
                }
                SEAM(k + 2);
            }
        }
        if (PH(base + 30)) { PHASE_BEGIN
            const float* fsrc = (l & 1) ? W_FB : W_YO;
            for (int m = gw; m < T; m += NGW) {
                f32x4 y[8], hh[8], g[8]; row_load(fsrc + (size_t)m * DM, lane, y); row_load(I_out + (size_t)m * DM, lane, hh); row_load(SN_L + 3 * DM, lane, g);
                const float rstd = rsqrtf(row_ss(y) * (1.0f / DM) + EPS);
#pragma unroll
                for (int j = 0; j < 8; ++j) hh[j] = hh[j] + y[j] * rstd * g[j];
                row_store(I_out + (size_t)m * DM, lane, hh);
                row_store_bf16(W_XN + (size_t)m * DM, lane, hh);
            }
        }
        SEAM(base + 30);
        if (PH(base + 31)) { PHASE_BEGIN
            pg8::Gemm g{W_XN, W_WPG + (size_t)l * DM * DM, T, DM, DM}; pg8::StaticOrder S; S.init(T, DM, G, bid);
            pg8::EpiPleGate E{W_YO, W_PP, DM};
            pg8::gemm_phase<pg8::EpiPleGate, pg8::StaticOrder, true, true>(lds, g, S, E, wave);
        }
        SEAM(base + 31);
        if (PH(base + 32)) { PHASE_BEGIN
            for (int m = gw; m < T; m += NGW) {
                f32x4 y[8], hh[8], g[8]; row_load(W_YO + (size_t)m * DM, lane, y); row_load(I_out + (size_t)m * DM, lane, hh); row_load(I_p_nm + (size_t)l * DM, lane, g);
                float rstd = rsqrtf(row_ss(y) * (1.0f / DM) + EPS);
#pragma unroll
                for (int j = 0; j < 8; ++j) hh[j] = hh[j] + y[j] * rstd * g[j];
                row_store(I_out + (size_t)m * DM, lane, hh);
                if (l + 1 < DEPTH) {
                    row_load(I_snorm + (size_t)(l + 1) * 4 * DM, lane, g);
                    rstd = rsqrtf(row_ss(hh) * (1.0f / DM) + EPS);
#pragma unroll
                    for (int j = 0; j < 8; ++j) hh[j] = hh[j] * rstd * g[j];
                    row_store_bf16(W_XN + (size_t)m * DM, lane, hh);
                }
            }
        }
        SEAM(base + 32);
    }

__global__ void __launch_bounds__(NWAVES * 64, 2) mk_fwd(Args args) {
    extern __shared__ __attribute__((aligned(16))) unsigned char lds_raw[];
    LAS unsigned char* lds = (LAS unsigned char*)lds_raw;
    volatile LAS unsigned* MISC = (volatile LAS unsigned*)(lds + MISC_OFF);
    const int wave = __builtin_amdgcn_readfirstlane((int)threadIdx.x >> 6);
    const int G = gridDim.x, bid = blockIdx.x;
    gu32* ctl = (gu32*)(args.ws + WS_CTL);
    for (int u = threadIdx.x; u < (LDS_BYTES - RING_BYTES) / 4; u += NWAVES * 64) ((LAS unsigned*)(lds + RING_BYTES))[u] = 0u;
    __syncthreads();
    const int lo = args.ph_lo, hi = args.ph_hi;
    const bool multi = (hi - lo) > 1;
    XcdBarrier bar; bar.bar = (unsigned*)(ctl + CW_BAR); bar.x = 0; bar.st = nullptr; bar.w = wave;
    if (multi) bar = xcd_barrier_post((unsigned*)(ctl + CW_BAR), MISC + 8);

    if (PH(0)) { PHASE_BEGIN
        LAS float* scr = (LAS float*)(lds + wave * 16384);
        int cum = 0;
        for (int l = 0; l < DEPTH; ++l) {
            cvt_matrix(I_w_in + (size_t)l * DM * ZREAL, DM, ZREAL, W_WIN + (size_t)l * ZW * DM, MapIn{}, cum, gw, NGW, scr, lane);
            cvt_matrix(I_w_uq + (size_t)l * QRANK * QW, QRANK, QW, W_WUQ + (size_t)l * QW * QRANK, MapUq{}, cum, gw, NGW, scr, lane);
            cvt_matrix(I_w_ukv + (size_t)l * KVRANK * KVW, KVRANK, KVW, W_WUKV + (size_t)l * KVW * KVRANK, MapId{}, cum, gw, NGW, scr, lane);
            cvt_matrix(I_w_out + (size_t)l * DM * DM, DM, DM, W_WOUT + (size_t)l * DM * DM, MapId{}, cum, gw, NGW, scr, lane);
            cvt_matrix(I_p_wp + (size_t)l * PLE * DM, PLE, DM, W_WPP + (size_t)l * DM * PLE, MapId{}, cum, gw, NGW, scr, lane);
            cvt_matrix(I_p_wg + (size_t)l * DM * DM, DM, DM, W_WPG + (size_t)l * DM * DM, MapId{}, cum, gw, NGW, scr, lane);
        }
        cvt_matrix(I_f_gu, DM, GU, W_WGU, MapGu{}, cum, gw, NGW, scr, lane);
        cvt_matrix(I_f_dn, FF, DM, W_WDN, MapId{}, cum, gw, NGW, scr, lane);
        for (int e = 0; e < NE; ++e) {
            cvt_matrix(I_m_gu + (size_t)e * DM * GU, DM, GU, W_MGU + (size_t)e * GU * DM, MapGu{}, cum, gw, NGW, scr, lane);
            cvt_matrix(I_m_dn + (size_t)e * FF * DM, FF, DM, W_MDN + (size_t)e * DM * FF, MapId{}, cum, gw, NGW, scr, lane);
        }
        for (int i = bid * 512 + tid; i < DEPTH * (ZW - ZREAL) * DM / 8; i += G * 512) {
            const int l = i / ((ZW - ZREAL) * DM / 8), r = i - l * ((ZW - ZREAL) * DM / 8);
            *(GAS v4u*)(W_WIN + (size_t)l * ZW * DM + (size_t)ZREAL * DM + (size_t)r * 8) = (v4u){0u, 0u, 0u, 0u};
        }
        for (int i = bid * 512 + tid; i < T * 32; i += G * 512) {
            const int t = i >> 5, k = i & 31;
            const float inv = 1.0f / powf(10000.0f, (float)(2 * k) / 64.0f);
            const float ang = (float)I_positions[t] * inv;
            const double rev = (double)ang * 0.15915494309189533577;
            const float fr = (float)(rev - floor(rev));
            W_COS[i] = __builtin_amdgcn_cosf(fr); W_SIN[i] = __builtin_amdgcn_sinf(fr);
        }
        for (int i = bid * 512 + tid; i < 1024; i += G * 512) {
            const float a0 = I_lbl[i], a1 = I_lbl[1024 + i], mx = fmaxf(a0, a1), e0 = expf(a0 - mx), e1 = expf(a1 - mx), p0 = e0 / (e0 + e1), p1 = e1 / (e0 + e1);
            W_LB[i] = p0 - p0; W_LB[1024 + i] = (p0 + p1) - p0;
        }
        for (int i = bid * 512 + tid; i < DEPTH * T * PLE / 4; i += G * 512) {
            const f32x4 v = ((const GAS f32x4*)I_pin)[i];
            typedef unsigned u32x2v __attribute__((ext_vector_type(2)));
            u32x2v w; w.x = pk2(v.x, v.y); w.y = pk2(v.z, v.w); ((GAS u32x2v*)W_PB)[i] = w;
        }
        for (int m = gw; m < T; m += NGW) {
            f32x4 v[8], g[8]; row_load(I_x + (size_t)m * DM, lane, v); row_load(I_snorm, lane, g);
            const float rstd = rsqrtf(row_ss(v) * (1.0f / DM) + EPS);
#pragma unroll
            for (int j = 0; j < 8; ++j) v[j] = v[j] * rstd * g[j];
            row_store_bf16(W_XN + (size_t)m * DM, lane, v);
        }
    }
    SEAM(0);

    layer_phases<0>(lo, hi, bar, lds, wave, G, bid);
    layer_phases<1>(lo, hi, bar, lds, wave, G, bid);
#undef PH
#undef SEAM
}

static bool phase_live(int ph) {
    if (ph == 0) return true;
    const int l = (ph - 1) / NPL, k = (ph - 1) % NPL;
    if ((l & 1) == 0) return !(k >= 8 && k <= 29);
    return true;
}
extern "C" void kernel_launch(void* const* d_in, const int* in_sizes, int n_in, void* d_out, int out_size, void* d_ws, size_t ws_size, hipStream_t stream) {
    static int grid = 0;
    if (grid == 0) {
        if (n_in != 20 || out_size != T * DM || ws_size < WS_END) { fprintf(stderr, "kernel_launch: shape/workspace mismatch (n_in %d out %d ws %zu need %zu)\n", n_in, out_size, ws_size, (size_t)WS_END); grid = -1; return; }
        int dev = 0, cus = 0;
        if (hipGetDevice(&dev) != hipSuccess || hipDeviceGetAttribute(&cus, hipDeviceAttributeMultiprocessorCount, dev) != hipSuccess) { grid = -1; return; }
        if (hipFuncSetAttribute((const void*)mk_fwd, hipFuncAttributeMaxDynamicSharedMemorySize, LDS_BYTES) != hipSuccess) { fprintf(stderr, "kernel_launch: hipFuncSetAttribute failed\n"); grid = -1; return; }
        (void)hipGetLastError();
        grid = cus;
    }
    if (grid < 0) return;
    (void)in_sizes;
    if (hipMemsetAsync((char*)d_ws + WS_CTL, 0, CTL_ZERO_BYTES, stream) != hipSuccess) return;
    Args a{};
    for (int i = 0; i < 20; ++i) a.in[i] = (const float*)d_in[i];
    a.out = (float*)d_out; a.ws = (unsigned char*)d_ws;
#if MK_ONE_LAUNCH
    a.ph_lo = 0; a.ph_hi = NPH;
    hipLaunchKernelGGL(mk_fwd, dim3(grid), dim3(NWAVES * 64), LDS_BYTES, stream, a);
#else
    for (int ph = 0; ph < NPH; ++ph) {
        if (!phase_live(ph)) continue;
        a.ph_lo = ph; a.ph_hi = ph + 1;
        hipLaunchKernelGGL(mk_fwd, dim3(grid), dim3(NWAVES * 64), LDS_BYTES, stream, a);
    }
#endif
}
```

```cpp
#include <hip/hip_runtime.h>
#include <cstdio>
#include <cstdint>
#ifndef MK_ONE_LAUNCH
#define MK_ONE_LAUNCH 1
#endif
__device__ __forceinline__ int hw_lane() { int l; asm volatile("v_mbcnt_lo_u32_b32 %0, -1, 0\n\tv_mbcnt_hi_u32_b32 %0, -1, %0" : "=v"(l)); return l; }
namespace pg8 {
#define PG8_LAS __attribute__((address_space(3)))
typedef unsigned short bf16_t;
typedef short bf16x8 __attribute__((ext_vector_type(8)));
typedef float f32x4 __attribute__((ext_vector_type(4)));
typedef unsigned u32x4 __attribute__((ext_vector_type(4)));
constexpr int BM = 256, BK = 64, HALF = 128, HTB = HALF * BK * 2  , STAGE_BYTES = 8 * HTB, NXCD = 8, WGM = 8;

__host__ __device__ __forceinline__ int lds_byte(int r, int c) { const int st = (r >> 4) * 2 + (c >> 5), rr = r & 15, cc = c & 31, ob = rr * 64 + cc * 2; return st * 1024 + (ob ^ (((ob >> 9) & 1) << 5)); }
__host__ __device__ __forceinline__ void stage_rc(int b, int& R, int& C) { const int st = b / 1024, sb = b % 1024, swz = sb ^ (((sb >> 9) & 1) << 5); R = (st >> 1) * 16 + swz / 64; C = (st & 1) * 32 + (swz % 64) / 2; }
__host__ __device__ __forceinline__ int perm32(int rho) { const int n = rho >> 4, i = rho & 15; return 8 * (i >> 2) + 4 * n + (i & 3); }

struct Unit { int pm, pn; };
struct Gemm { const bf16_t* A; const bf16_t* Bt; int M, N, K; };

struct StaticOrder {
    int nM, nN, nwg, G, c;
    __host__ __device__ void init(int M, int N, int G_, int c_) { nM = M / BM; nN = N / BM; nwg = nM * nN; G = G_; c = c_; }
    __host__ __device__ bool next(int i, Unit& u) const {
        const long L = (long)i * G + c; if (L >= nwg) return false;
        int wgid = (int)L; { const int q = nwg / NXCD, r = nwg % NXCD, xcd = wgid % NXCD, off = wgid / NXCD; wgid = (xcd < r ? xcd * (q + 1) : r * (q + 1) + (xcd - r) * q) + off; }
        const int nig = WGM * nN, gid = wgid / nig, fm = gid * WGM, gsz = (nM - fm) < WGM ? (nM - fm) : WGM;
        u.pm = fm + ((wgid % nig) % gsz); u.pn = (wgid % nig) / gsz; return true;
    }
    __device__ __forceinline__ void a_ready(const Unit&) const {}
    __device__ __forceinline__ void done(const Unit&) const {}
};

__device__ __forceinline__ unsigned cvt_pk_bf16(float lo, float hi) { unsigned r; asm volatile("v_cvt_pk_bf16_f32 %0, %1, %2" : "=v"(r) : "v"(lo), "v"(hi)); return r; }
typedef float f32x2 __attribute__((ext_vector_type(2)));

template <class Epi, class Sched, bool ALIGN_EPI = false, bool SP2 = false>
__device__ __forceinline__ void gemm_phase(PG8_LAS unsigned char* lds, const Gemm g, const Sched& S, const Epi& E, const int wid) {
    const int lane = hw_lane(), tid = wid * 64 + lane, wr = wid >> 2, wc = wid & 3, fr = lane & 15, fq = lane >> 4;
    int K = g.K; asm volatile("" : "+s"(K));
    const int nt = K / BK;
    unsigned voffA[2], voffB[2];
#pragma unroll
    for (int i = 0; i < 2; ++i) { int R, C; stage_rc(tid * 16 + i * 8192, R, C); const int Rb = Epi::PERM ? ((R & ~31) + perm32(R & 31)) : R;
        voffA[i] = (unsigned)(R * K + C) * 2u; voffB[i] = (unsigned)(Rb * K + C) * 2u; }
    const size_t kstep = (size_t)(BK * 2);
    const size_t hstep = (size_t)HALF * K * 2;
    const size_t tstep = 2 * hstep;
    const unsigned ldsw = (unsigned)wid * 1024u;
    const int aoff = lds_byte(wr * 64 + fr, fq * 8), boff = lds_byte(wc * 32 + fr, fq * 8);
#define PG8_SA(b, h) (((b) * 2 + (h)) * HTB)
#define PG8_SB(b, h) ((4 + (b) * 2 + (h)) * HTB)
#define PG8_STAGE(bufoff, gbase, voff) do { _Pragma("unroll") for (int _i = 0; _i < 2; ++_i) \
        __builtin_amdgcn_global_load_lds((const unsigned*)((const char*)(gbase) + (voff)[_i]), (PG8_LAS unsigned*)(lds + (bufoff) + ldsw + _i * 8192), 16, 0, 0); } while (0)
#define PG8_LDA(dst, b, h) do { _Pragma("unroll") for (int m = 0; m < 4; ++m) _Pragma("unroll") for (int k = 0; k < 2; ++k) dst[m][k] = *(const PG8_LAS bf16x8*)(lds + PG8_SA(b, h) + aoff + m * 2048 + k * 1024); } while (0)
#define PG8_LDB(dst, b, h) do { _Pragma("unroll") for (int n = 0; n < 2; ++n) _Pragma("unroll") for (int k = 0; k < 2; ++k) dst[n][k] = *(const PG8_LAS bf16x8*)(lds + PG8_SB(b, h) + boff + n * 2048 + k * 1024); } while (0)
#define PG8_MMA(ai, bj, At, Bt) do { __builtin_amdgcn_s_setprio(1); _Pragma("unroll") for (int m = 0; m < 4; ++m) _Pragma("unroll") for (int n = 0; n < 2; ++n) _Pragma("unroll") for (int k = 0; k < 2; ++k) \
        acc[ai][bj][m][n] = __builtin_amdgcn_mfma_f32_16x16x32_bf16(Bt[n][k], At[m][k], acc[ai][bj][m][n], 0, 0, 0); __builtin_amdgcn_s_setprio(0); } while (0)
#define PG8_WAIT_V(n) asm volatile("s_waitcnt vmcnt(" #n ")" ::: "memory")
#define PG8_WAIT_L(n) asm volatile("s_waitcnt lgkmcnt(" #n ")" ::: "memory")
#define PG8_BAR __builtin_amdgcn_s_barrier()
#define PG8_SCHED __builtin_amdgcn_sched_barrier(0)
    Unit cur, nxt; int ui = 0;
    if (!S.next(0, cur)) return;
    f32x4 acc[2][2][4][2];
#pragma unroll
    for (int a = 0; a < 2; ++a)
#pragma unroll
        for (int b = 0; b < 2; ++b)
#pragma unroll
            for (int m = 0; m < 4; ++m)
#pragma unroll
                for (int n = 0; n < 2; ++n) acc[a][b][m][n] = (f32x4){0.f, 0.f, 0.f, 0.f};
    bf16x8 At[4][2], B0[2][2], B1[2][2];
    const char* cA = (const char*)g.A + (size_t)cur.pm * tstep; const char* cB = (const char*)g.Bt + (size_t)cur.pn * tstep;
    S.a_ready(cur);
    if constexpr (SP2) {
        PG8_STAGE(PG8_SB(0, 0), cB, voffB); PG8_STAGE(PG8_SB(0, 1), cB + hstep, voffB); PG8_STAGE(PG8_SA(0, 0), cA, voffA); PG8_STAGE(PG8_SA(0, 1), cA + hstep, voffA);
        if (wr == 1) PG8_BAR;
        PG8_WAIT_V(2); PG8_BAR;
        PG8_STAGE(PG8_SB(1, 0), cB + kstep, voffB); PG8_STAGE(PG8_SA(1, 0), cA + kstep, voffA); PG8_STAGE(PG8_SB(1, 1), cB + hstep + kstep, voffB);
        PG8_WAIT_V(6); PG8_BAR;
    } else {
        PG8_STAGE(PG8_SB(0, 0), cB, voffB); PG8_STAGE(PG8_SA(0, 0), cA, voffA); PG8_STAGE(PG8_SB(0, 1), cB + hstep, voffB); PG8_STAGE(PG8_SA(0, 1), cA + hstep, voffA);
        if (wr == 1) PG8_BAR;
        PG8_WAIT_V(4); PG8_BAR;
        PG8_STAGE(PG8_SB(1, 0), cB + kstep, voffB); PG8_STAGE(PG8_SA(1, 0), cA + kstep, voffA); PG8_STAGE(PG8_SB(1, 1), cB + hstep + kstep, voffB);
        PG8_WAIT_V(6); PG8_BAR;
    }
    for (;;) {
        const bool has_next = S.next(ui + 1, nxt);
        const char* nA = has_next ? (const char*)g.A + (size_t)nxt.pm * tstep : cA; const char* nB = has_next ? (const char*)g.Bt + (size_t)nxt.pn * tstep : cB;
        for (int t = 0; t < nt; t += 2) {
            const bool last = (t == nt - 2);
            const char* a1 = cA + (size_t)(t + 1) * kstep;
            const char* a2 = last ? nA : cA + (size_t)(t + 2) * kstep; const char* b2 = last ? nB : cB + (size_t)(t + 2) * kstep;
            const char* a3 = a2 + kstep; const char* b3 = b2 + kstep;
            if (last && has_next) S.a_ready(nxt);
            if constexpr (SP2) {
            PG8_LDB(B0, 0, 0); PG8_LDB(B1, 0, 1); PG8_SCHED; PG8_LDA(At, 0, 0); PG8_STAGE(PG8_SA(1, 1), a1 + hstep, voffA);
            PG8_WAIT_V(8); PG8_WAIT_L(0); PG8_BAR; PG8_MMA(0, 0, At, B0); PG8_MMA(0, 1, At, B1); PG8_BAR; PG8_SCHED;
            PG8_LDA(At, 0, 1); PG8_STAGE(PG8_SB(0, 0), b2, voffB); PG8_STAGE(PG8_SB(0, 1), b2 + hstep, voffB); PG8_STAGE(PG8_SA(0, 0), a2, voffA);
            PG8_WAIT_V(8); PG8_WAIT_L(0); PG8_BAR; PG8_MMA(1, 0, At, B0); PG8_MMA(1, 1, At, B1); PG8_BAR; PG8_SCHED;
            PG8_LDB(B0, 1, 0); PG8_LDB(B1, 1, 1); PG8_SCHED; PG8_LDA(At, 1, 0); PG8_STAGE(PG8_SA(0, 1), a2 + hstep, voffA);
            PG8_WAIT_V(8); PG8_WAIT_L(0); PG8_BAR; PG8_MMA(0, 0, At, B0); PG8_MMA(0, 1, At, B1); PG8_BAR; PG8_SCHED;
            PG8_LDA(At, 1, 1); PG8_STAGE(PG8_SB(1, 0), b3, voffB); PG8_STAGE(PG8_SB(1, 1), b3 + hstep, voffB); PG8_STAGE(PG8_SA(1, 0), a3, voffA);
            PG8_WAIT_V(8); PG8_WAIT_L(0); PG8_BAR; PG8_MMA(1, 0, At, B0); PG8_MMA(1, 1, At, B1); PG8_BAR; PG8_SCHED;
            } else {
            PG8_LDB(B0, 0, 0); PG8_SCHED; PG8_LDA(At, 0, 0); PG8_STAGE(PG8_SA(1, 1), a1 + hstep, voffA);
            PG8_WAIT_L(8); PG8_BAR; PG8_WAIT_L(0); PG8_MMA(0, 0, At, B0); PG8_BAR; PG8_SCHED;
            PG8_LDB(B1, 0, 1); PG8_STAGE(PG8_SB(0, 0), b2, voffB);
            PG8_BAR; PG8_WAIT_L(0); PG8_MMA(0, 1, At, B1); PG8_BAR;
            PG8_LDA(At, 0, 1); PG8_STAGE(PG8_SA(0, 0), a2, voffA);
            PG8_BAR; PG8_WAIT_L(0); PG8_MMA(1, 0, At, B0); PG8_BAR; PG8_SCHED;
            PG8_STAGE(PG8_SB(0, 1), b2 + hstep, voffB);
            PG8_WAIT_V(6); PG8_BAR; PG8_MMA(1, 1, At, B1); PG8_BAR;
            PG8_LDB(B0, 1, 0); PG8_SCHED; PG8_LDA(At, 1, 0); PG8_STAGE(PG8_SA(0, 1), a2 + hstep, voffA);
            PG8_WAIT_L(8); PG8_BAR; PG8_WAIT_L(0); PG8_MMA(0, 0, At, B0); PG8_BAR; PG8_SCHED;
            PG8_LDB(B1, 1, 1); PG8_STAGE(PG8_SB(1, 0), b3, voffB);
            PG8_BAR; PG8_WAIT_L(0); PG8_MMA(0, 1, At, B1); PG8_BAR;
            PG8_LDA(At, 1, 1); PG8_STAGE(PG8_SA(1, 0), a3, voffA);
            PG8_BAR; PG8_WAIT_L(0); PG8_MMA(1, 0, At, B0); PG8_BAR; PG8_SCHED;
            PG8_STAGE(PG8_SB(1, 1), b3 + hstep, voffB);
            PG8_WAIT_V(6); PG8_BAR; PG8_MMA(1, 1, At, B1); PG8_BAR;
            }
        }
        if constexpr (ALIGN_EPI) { if (wr == 0) PG8_BAR; }
        if constexpr (!Epi::AFTER_DRAIN) { const int l2 = hw_lane(); E(acc, cur, wr, wc, l2 & 15, l2 >> 4); S.done(cur); }
        if (!has_next) break;
#pragma unroll
        for (int a = 0; a < 2; ++a)
#pragma unroll
            for (int b = 0; b < 2; ++b)
#pragma unroll
                for (int m = 0; m < 4; ++m)
#pragma unroll
                    for (int n = 0; n < 2; ++n) acc[a][b][m][n] = (f32x4){0.f, 0.f, 0.f, 0.f};
        cur = nxt; cA = nA; cB = nB; ++ui;
        if constexpr (ALIGN_EPI) { if (wr == 1) PG8_BAR; }
    }
    PG8_WAIT_V(0);
    if constexpr (!ALIGN_EPI) { if (wr == 0) PG8_BAR; }
    PG8_BAR;
    if constexpr (Epi::AFTER_DRAIN) { E.fused(acc, cur, wr, wc, fr, fq, lds, wid, lane); S.done(cur); }
#undef PG8_SA
#undef PG8_SB
#undef PG8_STAGE
#undef PG8_LDA
#undef PG8_LDB
#undef PG8_MMA
#undef PG8_WAIT_V
#undef PG8_WAIT_L
#undef PG8_BAR
#undef PG8_SCHED
}
}
#define GAS __attribute__((address_space(1)))
#define LAS __attribute__((address_space(3)))
typedef unsigned short bf16;
typedef unsigned v4u __attribute__((ext_vector_type(4)));
typedef float f32x4 __attribute__((ext_vector_type(4)));
typedef short bf16x8 __attribute__((ext_vector_type(8)));
typedef GAS unsigned gu32;
typedef GAS unsigned long long gu64;
#define RLX_AGENT __ATOMIC_RELAXED, __HIP_MEMORY_SCOPE_AGENT
#define LDS_WAIT() asm volatile("s_waitcnt lgkmcnt(0)" ::: "memory")
#define VM_WAIT() asm volatile("s_waitcnt vmcnt(0)" ::: "memory")
__device__ __forceinline__ unsigned long long rt() { return __builtin_amdgcn_s_memrealtime(); }
__device__ __forceinline__ unsigned f2bf(float f) { unsigned u = __builtin_bit_cast(unsigned, f); return (u + 0x7fffu + ((u >> 16) & 1u)) >> 16; }
__device__ __forceinline__ unsigned pk2(float lo, float hi) { return f2bf(lo) | (f2bf(hi) << 16); }

#define XB_TMO      128
#define XB_XCNT(j)  (256  + 64 * (j))
#define XB_XSUB(j)  (1280 + 64 * (j))
#define XB_XGEN(j)  (2304 + 64 * (j))
#define XB_TOP      3328
#define XB_TOPGEN   3392
#define XCD_BAR_WORDS 3456
#define XB_SPIN_CAP (1u << 18)

__device__ __forceinline__ unsigned xb_ld(unsigned* p)              { return __hip_atomic_load(p, __ATOMIC_RELAXED, __HIP_MEMORY_SCOPE_AGENT); }
__device__ __forceinline__ unsigned xb_add(unsigned* p, unsigned v) { return __hip_atomic_fetch_add(p, v, __ATOMIC_RELAXED, __HIP_MEMORY_SCOPE_AGENT); }
__device__ __forceinline__ unsigned xb_xcc_id() { return (unsigned)__builtin_amdgcn_s_getreg((3 << 11) | 20) & 0xFu; }
#define XB_SPIN(cond, bar) do { unsigned _sp = 0; while (cond) { __builtin_amdgcn_s_sleep(1); \
    if ((++_sp & 255u) == 0u) { if (xb_ld(&(bar)[XB_TMO])) break; if (_sp > XB_SPIN_CAP) { atomicAdd(&(bar)[XB_TMO], 1u); break; } } } } while (0)

struct XcdBarrier {
    unsigned* bar; unsigned x;
    int w;
    volatile LAS unsigned* st;
};

__device__ __forceinline__ XcdBarrier xcd_barrier_post(unsigned* bar, volatile LAS unsigned* st) {
    XcdBarrier b; b.bar = bar; b.x = xb_xcc_id(); b.st = st; b.w = __builtin_amdgcn_readfirstlane((int)threadIdx.x >> 6);
    if (threadIdx.x == 0) (void)xb_add(&bar[XB_XCNT(b.x)], 1u);
    return b;
}
__device__ __forceinline__ void xcd_barrier_complete(unsigned* bar, unsigned x, unsigned& nloc, unsigned& nx) {
    const unsigned G = gridDim.x * gridDim.y * gridDim.z;
    unsigned sum, cnt, mine, sp = 0u;
    for (;;) {
        sum = 0u; cnt = 0u; mine = 0u;
#pragma unroll
        for (unsigned j = 0; j < 16; ++j) { const unsigned c = xb_ld(&bar[XB_XCNT(j)]); sum += c; cnt += (c > 0u) ? 1u : 0u; mine = (j == x) ? c : mine; }
        if (sum == G) break;
        __builtin_amdgcn_s_sleep(1);
        if ((++sp & 255u) == 0u) { if (xb_ld(&bar[XB_TMO])) break; if (sp > XB_SPIN_CAP) { atomicAdd(&bar[XB_TMO], 1u); break; } }
    }
    nloc = mine > 0u ? mine : 1u; nx = cnt > 0u ? cnt : 1u;
}

__device__ __forceinline__ void xcd_barrier(const XcdBarrier& b) {
    asm volatile("s_waitcnt vmcnt(0)" ::: "memory");
    __syncthreads();
    if (b.w == 0 && hw_lane() == 0) {
        unsigned* bar = b.bar;
        __builtin_amdgcn_s_waitcnt(0);
        unsigned nloc = b.st[0], nx = b.st[1];
        if (nloc == 0u) { xcd_barrier_complete(bar, b.x, nloc, nx); b.st[0] = nloc; b.st[1] = nx; }
        const unsigned old = xb_add(&bar[XB_XSUB(b.x)], 1u);
        const unsigned gen = old / nloc;
        if (old + 1u == (gen + 1u) * nloc) {
            __builtin_amdgcn_fence(__ATOMIC_RELEASE, "agent");
            asm volatile("s_waitcnt vmcnt(0)" ::: "memory");
            const unsigned og = xb_add(&bar[XB_TOP], 1u);
            const unsigned tg = og / nx;
            if (og + 1u == (tg + 1u) * nx) xb_add(&bar[XB_TOPGEN], 1u);
            else XB_SPIN(xb_ld(&bar[XB_TOPGEN]) == tg, bar);
            __builtin_amdgcn_fence(__ATOMIC_ACQUIRE, "agent");
            xb_add(&bar[XB_XGEN(b.x)], 1u);
            asm volatile("s_waitcnt vmcnt(0)" ::: "memory");
        } else {
            XB_SPIN(xb_ld(&bar[XB_XGEN(b.x)]) == gen, bar);
            __builtin_amdgcn_fence(__ATOMIC_ACQUIRE, "agent");
            asm volatile("s_waitcnt vmcnt(0)" ::: "memory");
        }
    }
    __syncthreads();
}

namespace pg8 {
struct EpiBf16P {
    static constexpr bool PERM = true, AFTER_DRAIN = false;
    bf16_t* O; int ldc;
    __device__ __forceinline__ void operator()(const f32x4 (&acc)[2][2][4][2], const Unit& u, int wr, int wc, int fr, int fq) const {
        const int row0 = u.pm * BM + wr * 64 + fr, col0 = u.pn * BM + wc * 32 + 8 * fq;
#pragma unroll
        for (int ai = 0; ai < 2; ++ai)
#pragma unroll
            for (int m = 0; m < 4; ++m) { bf16_t* rowp = O + (size_t)(row0 + ai * HALF + m * 16) * ldc + col0;
#pragma unroll
                for (int bj = 0; bj < 2; ++bj) { const f32x4 v0 = acc[ai][bj][m][0], v1 = acc[ai][bj][m][1];
                    u32x4 w; w.x = cvt_pk_bf16(v0[0], v0[1]); w.y = cvt_pk_bf16(v0[2], v0[3]); w.z = cvt_pk_bf16(v1[0], v1[1]); w.w = cvt_pk_bf16(v1[2], v1[3]);
                    *(u32x4*)(rowp + bj * HALF) = w; } }
    }
};
struct EpiQRope {
    static constexpr bool PERM = true, AFTER_DRAIN = false;
    bf16_t* O; int ldc; const float* cosT; const float* sinT; float scale;
    __device__ __forceinline__ void operator()(const f32x4 (&acc)[2][2][4][2], const Unit& u, int wr, int wc, int fr, int fq) const {
        const int row0 = u.pm * BM + wr * 64 + fr, col0 = u.pn * BM + wc * 32 + 8 * fq;
#pragma unroll
        for (int ai = 0; ai < 2; ++ai)
#pragma unroll
            for (int m = 0; m < 4; ++m) { const int row = row0 + ai * HALF + m * 16; bf16_t* rowp = O + (size_t)row * ldc + col0;
#pragma unroll
                for (int bj = 0; bj < 2; ++bj) { f32x4 v0 = acc[ai][bj][m][0], v1 = acc[ai][bj][m][1];
                    const int hc = (col0 + bj * HALF) % 192;
                    if (hc >= 128) { const int i0 = (hc - 128) >> 1;
                        const f32x4 c4 = *(const f32x4*)(cosT + (size_t)row * 32 + i0), s4 = *(const f32x4*)(sinT + (size_t)row * 32 + i0);
                        f32x4 r0, r1;
                        r0[0] = v0[0] * c4[0] - v0[1] * s4[0]; r0[1] = v0[1] * c4[0] + v0[0] * s4[0];
                        r0[2] = v0[2] * c4[1] - v0[3] * s4[1]; r0[3] = v0[3] * c4[1] + v0[2] * s4[1];
                        r1[0] = v1[0] * c4[2] - v1[1] * s4[2]; r1[1] = v1[1] * c4[2] + v1[0] * s4[2];
                        r1[2] = v1[2] * c4[3] - v1[3] * s4[3]; r1[3] = v1[3] * c4[3] + v1[2] * s4[3];
                        v0 = r0; v1 = r1; }
                    v0 = v0 * scale; v1 = v1 * scale;
                    u32x4 w; w.x = cvt_pk_bf16(v0[0], v0[1]); w.y = cvt_pk_bf16(v0[2], v0[3]); w.z = cvt_pk_bf16(v1[0], v1[1]); w.w = cvt_pk_bf16(v1[2], v1[3]);
                    *(u32x4*)(rowp + bj * HALF) = w; } }
    }
};
struct EpiKV {
    static constexpr bool PERM = true, AFTER_DRAIN = false;
    bf16_t* K192; bf16_t* V;
    __device__ __forceinline__ void operator()(const f32x4 (&acc)[2][2][4][2], const Unit& u, int wr, int wc, int fr, int fq) const {
        const int row0 = u.pm * BM + wr * 64 + fr, c0 = wc * 32 + 8 * fq;
#pragma unroll
        for (int ai = 0; ai < 2; ++ai)
#pragma unroll
            for (int m = 0; m < 4; ++m) { const size_t row = (size_t)(row0 + ai * HALF + m * 16);
#pragma unroll
                for (int bj = 0; bj < 2; ++bj) { const f32x4 v0 = acc[ai][bj][m][0], v1 = acc[ai][bj][m][1];
                    u32x4 w; w.x = cvt_pk_bf16(v0[0], v0[1]); w.y = cvt_pk_bf16(v0[2], v0[3]); w.z = cvt_pk_bf16(v1[0], v1[1]); w.w = cvt_pk_bf16(v1[2], v1[3]);
                    bf16_t* dst = bj == 0 ? K192 + (row * 8 + u.pn) * 192 + c0 : V + (row * 8 + u.pn) * 128 + c0;
                    *(u32x4*)dst = w; } }
    }
};
struct EpiF32P {
    static constexpr bool PERM = false, AFTER_DRAIN = false;
    float* C; int ldc;
    __device__ __forceinline__ void operator()(const f32x4 (&acc)[2][2][4][2], const Unit& u, int wr, int wc, int fr, int fq) const {
        const int row0 = u.pm * BM + wr * 64 + fr, col0 = u.pn * BM + wc * 32 + 4 * fq;
#pragma unroll
        for (int ai = 0; ai < 2; ++ai)
#pragma unroll
            for (int m = 0; m < 4; ++m) { float* rowp = C + (size_t)(row0 + ai * HALF + m * 16) * ldc + col0;
#pragma unroll
                for (int bj = 0; bj < 2; ++bj)
#pragma unroll
                    for (int n = 0; n < 2; ++n) *(f32x4*)(rowp + bj * HALF + n * 16) = acc[ai][bj][m][n]; }
    }
};
struct EpiSwiGLU {
    static constexpr bool PERM = false, AFTER_DRAIN = false;
    bf16_t* H; int ldh; int npn;
    __device__ __forceinline__ void operator()(const f32x4 (&acc)[2][2][4][2], const Unit& u, int wr, int wc, int fr, int fq) const {
        const int row0 = u.pm * BM + wr * 64 + fr, j0 = (u.pn % npn) * 128 + wc * 16 + 4 * fq;
#pragma unroll
        for (int ai = 0; ai < 2; ++ai)
#pragma unroll
            for (int m = 0; m < 4; ++m) { bf16_t* rowp = H + (size_t)(row0 + ai * HALF + m * 16) * ldh + j0;
#pragma unroll
                for (int bj = 0; bj < 2; ++bj) { const f32x4 g = acc[ai][bj][m][0], uu = acc[ai][bj][m][1]; f32x4 h;
#pragma unroll
                    for (int i = 0; i < 4; ++i) h[i] = g[i] * __builtin_amdgcn_rcpf(1.0f + __builtin_amdgcn_exp2f(-1.4426950408889634f * g[i])) * uu[i];
                    typedef unsigned u32x2v __attribute__((ext_vector_type(2)));
                    u32x2v w; w.x = cvt_pk_bf16(h[0], h[1]); w.y = cvt_pk_bf16(h[2], h[3]);
                    *(u32x2v*)(rowp + bj * 64) = w; } }
    }
};
struct EpiPleGate {
    static constexpr bool PERM = false, AFTER_DRAIN = false;
    float* R; const float* P; int ldc;
    __device__ __forceinline__ void operator()(const f32x4 (&acc)[2][2][4][2], const Unit& u, int wr, int wc, int fr, int fq) const {
        const int row0 = u.pm * BM + wr * 64 + fr, col0 = u.pn * BM + wc * 32 + 4 * fq;
#pragma unroll
        for (int ai = 0; ai < 2; ++ai)
#pragma unroll
            for (int m = 0; m < 4; ++m) { const size_t off = (size_t)(row0 + ai * HALF + m * 16) * ldc + col0;
#pragma unroll
                for (int bj = 0; bj < 2; ++bj)
#pragma unroll
                    for (int n = 0; n < 2; ++n) { const f32x4 a = acc[ai][bj][m][n], p = *(const f32x4*)(P + off + bj * HALF + n * 16); f32x4 r;
#pragma unroll
                        for (int i = 0; i < 4; ++i) r[i] = p[i] * __builtin_amdgcn_rcpf(1.0f + __builtin_amdgcn_exp2f(-1.4426950408889634f * a[i]));
                        *(f32x4*)(R + off + bj * HALF + n * 16) = r; } }
    }
};
struct MoeOrder {
    int nM, nN, nwg, G, c; int tb1, tb2, tb3, tb4, tb5, tb6, tb7;
    __device__ __forceinline__ void init(const int* tbl, int nN_, int G_, int c_) { nM = tbl[8]; nN = nN_; nwg = nM * nN; G = G_; c = c_; tb1 = tbl[1]; tb2 = tbl[2]; tb3 = tbl[3]; tb4 = tbl[4]; tb5 = tbl[5]; tb6 = tbl[6]; tb7 = tbl[7]; }
    __device__ __forceinline__ bool next(int i, Unit& u) const {
        const long L = (long)i * G + c; if (L >= nwg) return false;
        int wgid = (int)L; { const int q = nwg / NXCD, r = nwg % NXCD, xcd = wgid % NXCD, off = wgid / NXCD; wgid = (xcd < r ? xcd * (q + 1) : r * (q + 1) + (xcd - r) * q) + off; }
        const int nig = WGM * nN, gid = wgid / nig, fm = gid * WGM, gsz = (nM - fm) < WGM ? (nM - fm) : WGM;
        const int pm = fm + ((wgid % nig) % gsz), pn = (wgid % nig) / gsz;
        const int e = (pm >= tb1) + (pm >= tb2) + (pm >= tb3) + (pm >= tb4) + (pm >= tb5) + (pm >= tb6) + (pm >= tb7);
        u.pm = pm; u.pn = e * nN + pn; return true;
    }
    __device__ __forceinline__ void a_ready(const Unit&) const {}
    __device__ __forceinline__ void done(const Unit&) const {}
};
struct EpiF32M {
    static constexpr bool PERM = false, AFTER_DRAIN = false;
    float* C; int ldc; int npn;
    __device__ __forceinline__ void operator()(const f32x4 (&acc)[2][2][4][2], const Unit& u, int wr, int wc, int fr, int fq) const {
        const int row0 = u.pm * BM + wr * 64 + fr, col0 = (u.pn % npn) * BM + wc * 32 + 4 * fq;
#pragma unroll
        for (int ai = 0; ai < 2; ++ai)
#pragma unroll
            for (int m = 0; m < 4; ++m) { float* rowp = C + (size_t)(row0 + ai * HALF + m * 16) * ldc + col0;
#pragma unroll
                for (int bj = 0; bj < 2; ++bj)
#pragma unroll
                    for (int n = 0; n < 2; ++n) *(f32x4*)(rowp + bj * HALF + n * 16) = acc[ai][bj][m][n]; }
    }
};
}

constexpr int T = 16384, DM = 2048, SEQ = 4096, NBATCH = 4, DEPTH = 2;
constexpr int ZW = 4864, ZREAL = 4800;
constexpr int CQ0 = 0, CKV0 = 384, KR0 = 640, HQ0 = 704, HF0 = 1728, HI0 = 2752, HG0 = 3776;
constexpr int QRANK = 384, KVRANK = 256, NH = 8, DQK = 192, QW = 1536, KVW = 2048;
constexpr int FF = 7168, GU = 14336, NE = 8, PLE = 256;
constexpr float EPS = 1e-6f;
constexpr float QSCALE = 0.07216878364870322f * 1.4426950408889634f;
constexpr int NWAVES = 8;
constexpr int LDS_BYTES = 147456;
constexpr int RING_BYTES = 131072;
constexpr int MISC_OFF = RING_BYTES + 320;

constexpr size_t MiB = 1ull << 20;
constexpr size_t rup(size_t x) { return (x + MiB - 1) & ~(MiB - 1); }
constexpr size_t WS_CTL = 0, CTL_ZERO_BYTES = 1 * MiB;
constexpr size_t WS_LB   = 1 * MiB;
constexpr size_t WS_COS  = 2 * MiB;
constexpr size_t WS_SIN  = 4 * MiB;
constexpr size_t WS_SELE = 6 * MiB;
constexpr size_t WS_SELG = 7 * MiB;
constexpr size_t WS_WIN  = 8 * MiB;
constexpr size_t WS_WUQ  = WS_WIN  + rup(2ull * ZW * DM * 2);
constexpr size_t WS_WUKV = WS_WUQ  + rup(2ull * QW * QRANK * 2);
constexpr size_t WS_WOUT = WS_WUKV + rup(2ull * KVW * KVRANK * 2);
constexpr size_t WS_WGU  = WS_WOUT + rup(2ull * DM * DM * 2);
constexpr size_t WS_WDN  = WS_WGU  + rup(1ull * GU * DM * 2);
constexpr size_t WS_MGU  = WS_WDN  + rup(1ull * DM * FF * 2);
constexpr size_t WS_MDN  = WS_MGU  + rup(8ull * GU * DM * 2);
constexpr size_t WS_WPP  = WS_MDN  + rup(8ull * DM * FF * 2);
constexpr size_t WS_WPG  = WS_WPP  + rup(2ull * DM * PLE * 2);
constexpr size_t WS_XN   = WS_WPG  + rup(2ull * DM * DM * 2);
constexpr size_t WS_Z    = WS_XN   + rup(1ull * T * DM * 2);
constexpr size_t WS_CQ   = WS_Z    + rup(1ull * T * ZW * 2);
constexpr size_t WS_CKV  = WS_CQ   + rup(1ull * T * QRANK * 2);
constexpr size_t WS_KPE  = WS_CKV  + rup(1ull * T * KVRANK * 2);
constexpr size_t WS_Q    = WS_KPE  + rup(1ull * T * 64 * 2);
constexpr size_t WS_K192 = WS_Q    + rup(1ull * T * QW * 2);
constexpr size_t WS_V    = WS_K192 + rup(1ull * T * QW * 2);
constexpr size_t WS_Y    = WS_V    + rup(1ull * T * 1024 * 2);
constexpr size_t WS_YO   = WS_Y    + rup(1ull * T * DM * 2);
constexpr size_t WS_PP   = WS_YO   + rup(1ull * T * DM * 4);
constexpr size_t WS_PB   = WS_PP   + rup(1ull * T * DM * 4);
constexpr int    MOE_ROWS = 34816;
constexpr size_t WS_POS  = WS_PB   + rup(2ull * T * PLE * 2);
constexpr size_t WS_TBL  = WS_POS  + rup(1ull * T * 8);
constexpr size_t WS_XP   = WS_TBL  + MiB;
constexpr size_t WS_YP   = WS_XP   + rup(1ull * MOE_ROWS * DM * 2);
constexpr size_t WS_HB   = WS_YP   + rup(1ull * MOE_ROWS * DM * 4);
constexpr size_t WS_END  = WS_HB   + rup(1ull * MOE_ROWS * FF * 2);

constexpr int CW_BAR = 4096;


namespace att {
typedef float f32x16 __attribute__((ext_vector_type(16)));
typedef short s16x4 __attribute__((ext_vector_type(4)));
typedef short b16x8 __attribute__((ext_vector_type(8)));
typedef unsigned u32x4v __attribute__((ext_vector_type(4)));
constexpr int KT = 64 * 384, VT = 64 * 256;
constexpr int LDS_V = 0, LDS_K = 2 * VT, LDS_WS = 2 * VT + 2 * KT, LDS_TOTAL = LDS_WS + 8 * 64 * 4;
constexpr float THR2 = 11.5415603f;
#define ATT_SBAR() __builtin_amdgcn_sched_barrier(0)
__device__ __forceinline__ int crow(int r, int hi) { return (r & 3) + 8 * (r >> 2) + 4 * hi; }
__device__ __forceinline__ unsigned cvtpk(float lo, float hi) { unsigned r; asm volatile("v_cvt_pk_bf16_f32 %0, %1, %2" : "=v"(r) : "v"(lo), "v"(hi)); return r; }
__device__ __forceinline__ int ksw(int key) { return ((key >> 1) & 3) | (((key >> 4) & 1) << 2); }
__device__ __forceinline__ int v_rd_base(int lane) { return ((lane & 3) << 3) | (((lane >> 2) & 3) << 6) | (((lane >> 4) & 1) << 5) | (((lane >> 5) & 1) << 8); }
constexpr int v_rd_off(int d0, int ks, int half) { return d0 * 512 + ks * 4096 + half * 2048; }

__device__ __forceinline__ void mask_tile(f32x16& p0, f32x16& p1, int dq) {
    const float NEG = -__builtin_inff();
#pragma unroll
    for (int r = 0; r < 16; ++r) {
        const int c = (r & 3) + 8 * (r >> 2);
        if (dq - c < 0) p0[r] = NEG;
        if (dq - c - 32 < 0) p1[r] = NEG;
    }
}
__device__ __forceinline__ void partialSM(f32x16& p0, f32x16& p1, float& m_reg, float& alpha) {
    float pmax = p0[0];
#pragma unroll
    for (int r = 1; r < 16; ++r) pmax = fmaxf(pmax, p0[r]);
#pragma unroll
    for (int r = 0; r < 16; ++r) pmax = fmaxf(pmax, p1[r]);
    { auto rr = __builtin_amdgcn_permlane32_swap(__float_as_uint(pmax), __float_as_uint(pmax), false, false);
      pmax = fmaxf(__uint_as_float(rr[0]), __uint_as_float(rr[1])); }
    float mn;
    if (__builtin_expect(__all((pmax - m_reg) <= THR2), 1)) { mn = m_reg; alpha = 1.f; }
    else { mn = fmaxf(m_reg, pmax); alpha = __builtin_amdgcn_exp2f(m_reg - mn); m_reg = mn; }
#pragma unroll
    for (int r = 0; r < 16; ++r) p0[r] = __builtin_amdgcn_exp2f(p0[r] - mn);
#pragma unroll
    for (int r = 0; r < 16; ++r) p1[r] = __builtin_amdgcn_exp2f(p1[r] - mn);
}
__device__ __forceinline__ void finishSM(const f32x16& p0, const f32x16& p1, float alpha, float& l_reg, b16x8& pa0, b16x8& pa1, b16x8& pa2, b16x8& pa3) {
    float ps = 0.f;
#pragma unroll
    for (int r = 0; r < 16; ++r) ps += p0[r];
#pragma unroll
    for (int r = 0; r < 16; ++r) ps += p1[r];
    { auto rr = __builtin_amdgcn_permlane32_swap(__float_as_uint(ps), __float_as_uint(ps), false, false);
      ps = __uint_as_float(rr[0]) + __uint_as_float(rr[1]); }
    l_reg = l_reg * alpha + ps;
#define ATT_PK4(P, B_, OUT) do { unsigned a0 = cvtpk(P[B_+0], P[B_+1]), a1 = cvtpk(P[B_+2], P[B_+3]);                          \
        unsigned b0 = cvtpk(P[B_+4], P[B_+5]), b1 = cvtpk(P[B_+6], P[B_+7]);                                             \
        auto r0 = __builtin_amdgcn_permlane32_swap(a0, b0, false, false); auto r1 = __builtin_amdgcn_permlane32_swap(a1, b1, false, false); \
        u32x4v w = {r0[0], r1[0], r0[1], r1[1]}; OUT = __builtin_bit_cast(b16x8, w); } while (0)
    ATT_PK4(p0, 0, pa0); ATT_PK4(p0, 8, pa1); ATT_PK4(p1, 0, pa2); ATT_PK4(p1, 8, pa3);
#undef ATT_PK4
}
template <int KB>
__device__ __forceinline__ void qkt(f32x16& p0, f32x16& p1, const LAS unsigned char* const (&kb4)[4], const b16x8 (&qr)[12]) {
    p0 = f32x16{}; p1 = f32x16{};
#pragma unroll
    for (int d0 = 0; d0 < 12; ++d0) {
        const LAS unsigned char* a = kb4[d0 & 3] + KB * KT + (d0 >> 2) * 128;
        const b16x8 b0 = *(const LAS b16x8*)a;
        const b16x8 b1 = *(const LAS b16x8*)(a + 32 * 384);
        p0 = __builtin_amdgcn_mfma_f32_32x32x16_bf16(b0, qr[d0], p0, 0, 0, 0);
        p1 = __builtin_amdgcn_mfma_f32_32x32x16_bf16(b1, qr[d0], p1, 0, 0, 0);
    }
}
template <int VB>
__device__ __forceinline__ void pv_tile(f32x16 (&o)[4], int vb0, b16x8 pa0, b16x8 pa1, b16x8 pa2, b16x8 pa3) {
#define ATT_TRRD(dst, off) asm volatile("ds_read_b64_tr_b16 %0, %1 offset:%2" : "=&v"(dst) : "v"(vb0), "i"(off) : "memory")
#define ATT_PV_D0(d0) do { s16x4 l0, l1, l2, l3, h0, h1, h2, h3; constexpr int b_ = LDS_V + VB * VT + v_rd_off(d0, 0, 0); \
        ATT_TRRD(l0, b_); ATT_TRRD(h0, b_ + 2048); ATT_TRRD(l1, b_ + 4096); ATT_TRRD(h1, b_ + 6144); ATT_TRRD(l2, b_ + 8192); ATT_TRRD(h2, b_ + 10240); ATT_TRRD(l3, b_ + 12288); ATT_TRRD(h3, b_ + 14336); \
        asm volatile("s_waitcnt lgkmcnt(0)" ::: "memory"); ATT_SBAR();   \
        o[d0] = __builtin_amdgcn_mfma_f32_32x32x16_bf16(pa0, (b16x8){l0[0], l0[1], l0[2], l0[3], h0[0], h0[1], h0[2], h0[3]}, o[d0], 0, 0, 0);   \
        o[d0] = __builtin_amdgcn_mfma_f32_32x32x16_bf16(pa1, (b16x8){l1[0], l1[1], l1[2], l1[3], h1[0], h1[1], h1[2], h1[3]}, o[d0], 0, 0, 0);   \
        o[d0] = __builtin_amdgcn_mfma_f32_32x32x16_bf16(pa2, (b16x8){l2[0], l2[1], l2[2], l2[3], h2[0], h2[1], h2[2], h2[3]}, o[d0], 0, 0, 0);   \
        o[d0] = __builtin_amdgcn_mfma_f32_32x32x16_bf16(pa3, (b16x8){l3[0], l3[1], l3[2], l3[3], h3[0], h3[1], h3[2], h3[3]}, o[d0], 0, 0, 0); } while (0)
    ATT_PV_D0(0); ATT_PV_D0(1); ATT_PV_D0(2); ATT_PV_D0(3);
#undef ATT_PV_D0
#undef ATT_TRRD
}

__device__ __forceinline__ void attn_block(const bf16* Qg, const bf16* Kg, const bf16* Vg, bf16* Og, int h, int qb, LAS unsigned char* lds, int wave, int lane) {
    const int r32 = lane & 31, hi = lane >> 5;
    const int P0 = qb * 256, NT = 4 * (qb + 1);
    const int qlo = P0 + wave * 32, qm = qlo + r32 - 4 * hi;
    unsigned koff[3], voff[2];
#pragma unroll
    for (int i = 0; i < 3; ++i) { const int o = (wave + 8 * i) * 1024 + lane * 16, key = o / 384, cc = (o - key * 384) >> 4, c = cc ^ ksw(key); koff[i] = (unsigned)(key * (8 * 384) + c * 16); }
#pragma unroll
    for (int i = 0; i < 2; ++i) { const int o = (wave + 8 * i) * 1024 + lane * 16, sub = o >> 9, kkhi = sub >> 2, cblk = sub & 3, rem = (o & 511) >> 1, kklo = rem >> 5, cl = rem & 31;
        const int kk = kkhi * 8 + kklo, k = (kk & ~0xC) | ((kk & 4) << 1) | ((kk & 8) >> 1), c = cblk * 32 + cl; voff[i] = (unsigned)(k * (8 * 256) + c * 2); }
    const char* kt = (const char*)(Kg + (size_t)h * 192);
    const char* vt = (const char*)(Vg + (size_t)h * 128);
#define ATT_ISSUE(BUF) do { \
        _Pragma("unroll") for (int _i = 0; _i < 3; ++_i) __builtin_amdgcn_global_load_lds((const unsigned*)(kt + koff[_i]), (LAS unsigned*)(lds + LDS_K + (BUF) * KT + (wave + 8 * _i) * 1024), 16, 0, 0); \
        _Pragma("unroll") for (int _i = 0; _i < 2; ++_i) __builtin_amdgcn_global_load_lds((const unsigned*)(vt + voff[_i]), (LAS unsigned*)(lds + LDS_V + (BUF) * VT + (wave + 8 * _i) * 1024), 16, 0, 0); \
        kt += 64 * 8 * 384; vt += 64 * 8 * 256; } while (0)
    b16x8 qr[12];
    { const bf16* qrow = Qg + ((size_t)(qlo + r32) * 8 + h) * 192 + hi * 8;
#pragma unroll
      for (int d0 = 0; d0 < 12; ++d0) qr[d0] = *(const GAS b16x8*)(qrow + d0 * 16); }
    ATT_ISSUE(0);
    const int ks_ = ksw(r32);
    const LAS unsigned char* const kb4[4] = { lds + LDS_K + r32 * 384 + (((0 + hi) ^ ks_) << 4), lds + LDS_K + r32 * 384 + (((2 + hi) ^ ks_) << 4),
                                              lds + LDS_K + r32 * 384 + (((4 + hi) ^ ks_) << 4), lds + LDS_K + r32 * 384 + (((6 + hi) ^ ks_) << 4) };
    const int vb0 = (int)((unsigned)(size_t)lds) + v_rd_base(lane);
    LAS float* al_l = (LAS float*)(lds + LDS_WS) + wave * 64; LAS float* li_l = al_l + 32;
    float m_reg = -1e30f, l_reg = 0.f; f32x16 o[4] = {};
#define ATT_RESC(a) do { if (__any((a) < 1.f)) { if (hi == 0) al_l[r32] = (a); asm volatile("s_waitcnt lgkmcnt(0)" ::: "memory");              \
                     _Pragma("unroll") for (int d_ = 0; d_ < 4; ++d_) _Pragma("unroll") for (int r = 0; r < 16; ++r) o[d_][r] *= al_l[crow(r, hi)]; } } while (0)
#define ATT_COMPUTE(BUF, t) do { f32x16 p0, p1; float alpha; b16x8 pa0, pa1, pa2, pa3; const int kb_ = (t) * 64; \
        qkt<BUF>(p0, p1, kb4, qr); \
        if (kb_ + 63 > qlo) mask_tile(p0, p1, qm - kb_); \
        partialSM(p0, p1, m_reg, alpha); finishSM(p0, p1, alpha, l_reg, pa0, pa1, pa2, pa3); ATT_RESC(alpha); \
        pv_tile<BUF>(o, vb0, pa0, pa1, pa2, pa3); } while (0)
    for (int t = 0; t < NT; t += 2) {
        ATT_ISSUE(1);
        asm volatile("s_waitcnt vmcnt(5)" ::: "memory"); __builtin_amdgcn_s_barrier(); asm volatile("" ::: "memory");
        ATT_COMPUTE(0, t);
        asm volatile("s_waitcnt lgkmcnt(0)" ::: "memory"); __builtin_amdgcn_s_barrier(); asm volatile("" ::: "memory");
        if (t + 2 < NT) { ATT_ISSUE(0); asm volatile("s_waitcnt vmcnt(5)" ::: "memory"); }
        else { asm volatile("s_waitcnt vmcnt(0)" ::: "memory"); }
        __builtin_amdgcn_s_barrier(); asm volatile("" ::: "memory");
        ATT_COMPUTE(1, t + 1);
        asm volatile("s_waitcnt lgkmcnt(0)" ::: "memory"); __builtin_amdgcn_s_barrier(); asm volatile("" ::: "memory");
    }
    if (hi == 0) li_l[r32] = l_reg;
    asm volatile("s_waitcnt lgkmcnt(0)" ::: "memory");
    float rli[16];
#pragma unroll
    for (int r = 0; r < 16; ++r) rli[r] = __builtin_amdgcn_rcpf(li_l[crow(r, hi)]);
    bf16* Ow = Og + (size_t)qlo * 2048 + h * 128;
#pragma unroll
    for (int r = 0; r < 16; ++r) { const int orow = crow(r, hi);
#pragma unroll
        for (int d0 = 0; d0 < 4; ++d0) { const float v = o[d0][r] * rli[r]; const float vn = __shfl_xor(v, 1);
            if ((r32 & 1) == 0) *(GAS unsigned*)(Ow + (size_t)orow * 2048 + d0 * 32 + r32) = cvtpk(v, vn); } }
#undef ATT_ISSUE
#undef ATT_RESC
#undef ATT_COMPUTE
}
}
__device__ __forceinline__ float bflo(unsigned w) { return __builtin_bit_cast(float, w << 16); }
__device__ __forceinline__ float bfhi(unsigned w) { return __builtin_bit_cast(float, w & 0xffff0000u); }
__device__ __forceinline__ float bf2f(bf16 b) { return __builtin_bit_cast(float, ((unsigned)b) << 16); }
__device__ __forceinline__ float wave_sum(float v) {
#pragma unroll
    for (int o = 1; o < 64; o <<= 1) v += __shfl_xor(v, o);
    return v;
}
__device__ __forceinline__ float wave_max(float v) {
#pragma unroll
    for (int o = 1; o < 64; o <<= 1) v = fmaxf(v, __shfl_xor(v, o));
    return v;
}
__device__ __forceinline__ float sigmoidf_(float x) { return 1.0f / (1.0f + __expf(-x)); }
__device__ __forceinline__ float siluf_(float x) { return x / (1.0f + __expf(-x)); }

struct MapId { __device__ __forceinline__ int operator()(int n) const { return n; } };
struct MapIn { __device__ __forceinline__ int operator()(int n) const { if (n < KR0 || n >= KR0 + 64) return n; const int i = n - KR0; return KR0 + (i < 32 ? 2 * i : 2 * (i - 32) + 1); } };
struct MapUq { __device__ __forceinline__ int operator()(int n) const { const int h = n / DQK, d = n - h * DQK; if (d < 128) return n; const int i = d - 128; return h * DQK + 128 + (i < 32 ? 2 * i : 2 * (i - 32) + 1); } };
struct MapGu { __device__ __forceinline__ int operator()(int n) const { const int isu = n >= FF ? 1 : 0, j = n - isu * FF; return 32 * (j >> 4) + 16 * isu + (j & 15); } };

template <class Map>
__device__ __forceinline__ void cvt_item(const float* W, int K, int N, bf16* WT, Map map, LAS float* scr, int item, int lane) {
    const int nblk = N / 32, kb = item / nblk, nb = item - kb * nblk, k0 = 64 * kb, n0 = 32 * nb;
    const int kr = lane >> 3, c4 = lane & 7;
#pragma unroll
    for (int i = 0; i < 8; ++i) {
        const f32x4 v = *(const GAS f32x4*)(W + (size_t)(k0 + 8 * i + kr) * N + n0 + 4 * c4);
        LAS float* s = scr + (8 * i + kr) * 33 + 4 * c4;
        s[0] = v.x; s[1] = v.y; s[2] = v.z; s[3] = v.w;
    }
    LDS_WAIT(); asm volatile("" ::: "memory");
#pragma unroll
    for (int j = 0; j < 4; ++j) {
        const int n = (lane >> 3) + 8 * j;
        const LAS float* s = scr + (8 * c4) * 33 + n;
        v4u o; o.x = pk2(s[0], s[33]); o.y = pk2(s[66], s[99]); o.z = pk2(s[132], s[165]); o.w = pk2(s[198], s[231]);
        *(GAS v4u*)(WT + (size_t)map(n0 + n) * K + k0 + 8 * c4) = o;
    }
    LDS_WAIT(); asm volatile("" ::: "memory");
}
template <class Map>
__device__ __forceinline__ void cvt_matrix(const float* W, int K, int N, bf16* WT, Map map, int& cum, int gw, int NGW, LAS float* scr, int lane) {
    const int nitems = (K / 64) * (N / 32);
    const int first = (gw - (cum % NGW) + NGW) % NGW;
    for (int it = first; it < nitems; it += NGW) cvt_item(W, K, N, WT, map, scr, it, lane);
    cum += nitems;
}

__device__ __forceinline__ void row_load(const float* row, int lane, f32x4 (&v)[8]) {
#pragma unroll
    for (int j = 0; j < 8; ++j) v[j] = ((const GAS f32x4*)row)[lane + 64 * j];
}
__device__ __forceinline__ void row_store(float* row, int lane, const f32x4 (&v)[8]) {
#pragma unroll
    for (int j = 0; j < 8; ++j) ((GAS f32x4*)row)[lane + 64 * j] = v[j];
}
__device__ __forceinline__ float row_ss(const f32x4 (&v)[8]) {
    float s = 0.f;
#pragma unroll
    for (int j = 0; j < 8; ++j) s += (v[j].x * v[j].x + v[j].y * v[j].y) + (v[j].z * v[j].z + v[j].w * v[j].w);
    return wave_sum(s);
}
__device__ __forceinline__ void row_store_bf16(bf16* row, int lane, const f32x4 (&v)[8]) {
    typedef unsigned u32x2v __attribute__((ext_vector_type(2)));
#pragma unroll
    for (int j = 0; j < 8; ++j) { u32x2v w; w.x = pk2(v[j].x, v[j].y); w.y = pk2(v[j].z, v[j].w); ((GAS u32x2v*)row)[lane + 64 * j] = w; }
}

struct Args { const float* in[20]; float* out; unsigned char* ws; int ph_lo, ph_hi; };

constexpr int NPL = 33;
constexpr int NPH = 1 + DEPTH * NPL;

#define CAS __attribute__((address_space(4)))
typedef const float* cfp_t;
#define KARG_IN(k) (*(const cfp_t CAS*)(ka + 8 * (k)))
__device__ __forceinline__ int launder_v(int v) { asm volatile("" : "+v"(v)); return v; }
__device__ __forceinline__ const CAS unsigned char* launder_ka() { const CAS unsigned char* p = (const CAS unsigned char*)__builtin_amdgcn_kernarg_segment_ptr(); asm volatile("" : "+s"(p)); return p; }
#define PHASE_BEGIN const int lane = hw_lane(), tid = wave * 64 + lane; const CAS unsigned char* ka = launder_ka(); unsigned char* const wsl = *(unsigned char* const CAS*)(ka + 168); \
    const int gw = bid * NWAVES + wave, NGW = G * NWAVES; (void)tid; (void)lane; (void)ka; (void)wsl; (void)gw; (void)NGW;
#define I_x          (KARG_IN(0))
#define I_pin        (KARG_IN(1))
#define I_positions  ((const int*)KARG_IN(2))
#define I_snorm      (KARG_IN(3))
#define I_w_in       (KARG_IN(4))
#define I_qnorm      (KARG_IN(5))
#define I_kvnorm     (KARG_IN(6))
#define I_w_uq       (KARG_IN(7))
#define I_w_ukv      (KARG_IN(8))
#define I_lbl        (KARG_IN(9))
#define I_onorm      (KARG_IN(10))
#define I_w_out      (KARG_IN(11))
#define I_f_gu       (KARG_IN(12))
#define I_f_dn       (KARG_IN(13))
#define I_m_rt       (KARG_IN(14))
#define I_m_gu       (KARG_IN(15))
#define I_m_dn       (KARG_IN(16))
#define I_p_wp       (KARG_IN(17))
#define I_p_wg       (KARG_IN(18))
#define I_p_nm       (KARG_IN(19))
#define I_out        (*(float* const CAS*)(ka + 160))
#define W_LB   ((float*)(wsl + WS_LB))
#define W_COS  ((float*)(wsl + WS_COS))
#define W_SIN  ((float*)(wsl + WS_SIN))
#define W_SELE ((int*)(wsl + WS_SELE))
#define W_SELG ((float*)(wsl + WS_SELG))
#define W_WIN  ((bf16*)(wsl + WS_WIN))
#define W_WUQ  ((bf16*)(wsl + WS_WUQ))
#define W_WUKV ((bf16*)(wsl + WS_WUKV))
#define W_WOUT ((bf16*)(wsl + WS_WOUT))
#define W_WGU  ((bf16*)(wsl + WS_WGU))
#define W_WDN  ((bf16*)(wsl + WS_WDN))
#define W_MGU  ((bf16*)(wsl + WS_MGU))
#define W_MDN  ((bf16*)(wsl + WS_MDN))
#define W_WPP  ((bf16*)(wsl + WS_WPP))
#define W_WPG  ((bf16*)(wsl + WS_WPG))
#define W_XN   ((bf16*)(wsl + WS_XN))
#define W_Z    ((bf16*)(wsl + WS_Z))
#define W_CQ   ((bf16*)(wsl + WS_CQ))
#define W_CKV  ((bf16*)(wsl + WS_CKV))
#define W_KPE  ((bf16*)(wsl + WS_KPE))
#define W_Q    ((bf16*)(wsl + WS_Q))
#define W_K192 ((bf16*)(wsl + WS_K192))
#define W_V    ((bf16*)(wsl + WS_V))
#define W_Y    ((bf16*)(wsl + WS_Y))
#define W_YO   ((float*)(wsl + WS_YO))
#define W_PP   ((float*)(wsl + WS_PP))
#define W_PB   ((bf16*)(wsl + WS_PB))
#define W_POS  ((int*)(wsl + WS_POS))
#define W_TBL  ((int*)(wsl + WS_TBL))
#define W_XP   ((bf16*)(wsl + WS_XP))
#define W_YP   ((float*)(wsl + WS_YP))
#define W_HB   ((bf16*)(wsl + WS_HB))

#define PH(k) (lo <= (k) && (k) < hi)
#define SEAM(k) do { if (lo <= (k) && (k) + 1 < hi) xcd_barrier(bar); } while (0)

template <int l>
__device__ __forceinline__ void layer_phases(const int lo, const int hi, const XcdBarrier& bar, LAS unsigned char* lds, const int wave, const int G, const int bid) {
        const int base = 1 + l * NPL;
#define SN_L (I_snorm + (size_t)l * 4 * DM)
        if (PH(base + 0)) { PHASE_BEGIN
            pg8::Gemm g{W_XN, W_WIN + (size_t)l * ZW * DM, T, ZW, DM}; pg8::StaticOrder S; S.init(T, ZW, G, bid);
            pg8::EpiBf16P E{W_Z, ZW};
            pg8::gemm_phase<pg8::EpiBf16P, pg8::StaticOrder, true, true>(lds, g, S, E, wave);
        }
        SEAM(base + 0);
        if (PH(base + 1)) { PHASE_BEGIN
            const float* qn = I_qnorm + (size_t)l * QRANK; const float* kn = I_kvnorm + (size_t)l * KVRANK;
            for (int m = gw; m < T; m += NGW) {
                const bf16* zr = W_Z + (size_t)m * ZW;
                unsigned a[3]; float ss = 0.f;
#pragma unroll
                for (int j = 0; j < 3; ++j) { a[j] = *(const GAS unsigned*)(zr + CQ0 + 2 * lane + 128 * j); const float lo_ = bflo(a[j]), hi_ = bfhi(a[j]); ss += lo_ * lo_ + hi_ * hi_; }
                float rstd = rsqrtf(wave_sum(ss) * (1.0f / QRANK) + EPS);
#pragma unroll
                for (int j = 0; j < 3; ++j) { const int c = 2 * lane + 128 * j; *(GAS unsigned*)(W_CQ + (size_t)m * QRANK + c) = pk2(bflo(a[j]) * rstd * qn[c], bfhi(a[j]) * rstd * qn[c + 1]); }
                unsigned b2[2]; ss = 0.f;
#pragma unroll
                for (int j = 0; j < 2; ++j) { b2[j] = *(const GAS unsigned*)(zr + CKV0 + 2 * lane + 128 * j); const float lo_ = bflo(b2[j]), hi_ = bfhi(b2[j]); ss += lo_ * lo_ + hi_ * hi_; }
                rstd = rsqrtf(wave_sum(ss) * (1.0f / KVRANK) + EPS);
#pragma unroll
                for (int j = 0; j < 2; ++j) { const int c = 2 * lane + 128 * j; *(GAS unsigned*)(W_CKV + (size_t)m * KVRANK + c) = pk2(bflo(b2[j]) * rstd * kn[c], bfhi(b2[j]) * rstd * kn[c + 1]); }
                if (lane < 32) { const unsigned w = *(const GAS unsigned*)(zr + KR0 + 2 * lane); const float x1 = bflo(w), x2 = bfhi(w), c = W_COS[(size_t)m * 32 + lane], s = W_SIN[(size_t)m * 32 + lane];
                    const unsigned kp = pk2(x1 * c - x2 * s, x2 * c + x1 * s);
#pragma unroll
                    for (int hh_ = 0; hh_ < NH; ++hh_) *(GAS unsigned*)(W_K192 + ((size_t)m * NH + hh_) * DQK + 128 + 2 * lane) = kp; }
            }
        }
        SEAM(base + 1);
        if (PH(base + 2)) { PHASE_BEGIN
            { pg8::Gemm g{W_CQ, W_WUQ + (size_t)l * QW * QRANK, T, QW, QRANK}; pg8::StaticOrder S; S.init(T, QW, G, bid);
              pg8::EpiQRope E{W_Q, QW, W_COS, W_SIN, QSCALE};
              pg8::gemm_phase<pg8::EpiQRope, pg8::StaticOrder, true, true>(lds, g, S, E, wave); }
            { pg8::Gemm g{W_CKV, W_WUKV + (size_t)l * KVW * KVRANK, T, KVW, KVRANK}; pg8::StaticOrder S; S.init(T, KVW, G, bid);
              pg8::EpiKV E{W_K192, W_V};
              pg8::gemm_phase<pg8::EpiKV, pg8::StaticOrder, true, true>(lds, g, S, E, wave); }
            { pg8::Gemm g{W_PB + (size_t)l * T * PLE, W_WPP + (size_t)l * DM * PLE, T, DM, PLE}; pg8::StaticOrder S; S.init(T, DM, G, bid);
              pg8::EpiF32P E{W_PP, DM};
              pg8::gemm_phase<pg8::EpiF32P, pg8::StaticOrder, true, true>(lds, g, S, E, wave); }
        }
        SEAM(base + 2);
        if (PH(base + 3)) { PHASE_BEGIN
            for (int u = bid; u < NBATCH * NH; u += G) {
                const int b = u / NH, h = u % NH;
                LAS float* qs = (LAS float*)lds; LAS float* fs = qs + 2048; LAS float* ks = fs + 2048; LAS float* vs = ks + 2048; LAS float* red = vs + 2048; LAS float* og = red + 8192;
                const int v = tid & 127, kq = tid >> 7, k0 = 32 * kq;
                float S[32];
#pragma unroll
                for (int i = 0; i < 32; ++i) S[i] = 0.f;
                const float* lbp = W_LB + (size_t)l * 1024 + h * 128;
                for (int c16 = 0; c16 < SEQ / 16; ++c16) {
                    for (int idx = tid; idx < 2048; idx += 512) {
                        const int t = idx >> 7, ch = idx & 127; const bf16* zr = W_Z + ((size_t)b * SEQ + c16 * 16 + t) * ZW + h * 128 + ch;
                        const float qr = bf2f(zr[HQ0]), fr = bf2f(zr[HF0]), ir = bf2f(zr[HI0]), lbv = lbp[ch];
                        qs[idx] = siluf_(qr); fs[idx] = lbv + (1.0f - lbv) * sigmoidf_(fr); ks[idx] = (1.0f - lbv) * sigmoidf_(-fr); vs[idx] = ir;
                    }
                    __syncthreads();
                    for (int t = 0; t < 16; ++t) {
                        const float vt = vs[t * 128 + v]; float po = 0.f;
#pragma unroll
                        for (int i = 0; i < 32; ++i) { S[i] = fs[t * 128 + k0 + i] * S[i] + ks[t * 128 + k0 + i] * vt; po += S[i] * qs[t * 128 + k0 + i]; }
                        red[(t * 4 + kq) * 128 + v] = po;
                    }
                    __syncthreads();
                    for (int idx = tid; idx < 2048; idx += 512) { const int t = idx >> 7, ch = idx & 127; og[idx] = (red[(t * 4 + 0) * 128 + ch] + red[(t * 4 + 1) * 128 + ch]) + (red[(t * 4 + 2) * 128 + ch] + red[(t * 4 + 3) * 128 + ch]); }
                    __syncthreads();
                    for (int t = wave; t < 16; t += 8) {
                        const float x0 = og[t * 128 + lane], x1 = og[t * 128 + 64 + lane];
                        const float rstd = rsqrtf(wave_sum(x0 * x0 + x1 * x1) * (1.0f / 128.0f) + EPS);
                        const size_t tok = (size_t)b * SEQ + c16 * 16 + t; const bf16* zr = W_Z + tok * ZW + HG0 + h * 128;
                        const float g0 = bf2f(zr[lane]), g1 = bf2f(zr[64 + lane]);
                        const float* on = I_onorm + (size_t)l * 128;
                        W_Y[tok * DM + 1024 + h * 128 + lane] = (bf16)f2bf(x0 * rstd * on[lane] * siluf_(g0));
                        W_Y[tok * DM + 1024 + h * 128 + 64 + lane] = (bf16)f2bf(x1 * rstd * on[64 + lane] * siluf_(g1));
                    }
                    __syncthreads();
                }
            }
            {
                const int vcu = (G % 8 == 0) ? (bid % 8) * (G / 8) + bid / 8 : bid;
                for (int u = vcu; u < NBATCH * NH * 8; u += G) {
                    const int bh = u >> 3, xq = u & 7, b = bh >> 3, h = bh & 7;
                    for (int pass = 0; pass < 2; ++pass) {
                        const int qb = pass ? xq : 15 - xq;
                        att::attn_block(W_Q + (size_t)b * SEQ * QW, W_K192 + (size_t)b * SEQ * QW, W_V + (size_t)b * SEQ * 1024, W_Y + (size_t)b * SEQ * DM, h, qb, lds, wave, lane);
                    }
                }
            }
        }
        SEAM(base + 3);
        if (PH(base + 4)) { PHASE_BEGIN
            pg8::Gemm g{W_Y, W_WOUT + (size_t)l * DM * DM, T, DM, DM}; pg8::StaticOrder S; S.init(T, DM, G, bid);
            pg8::EpiF32P E{W_YO, DM};
            pg8::gemm_phase<pg8::EpiF32P, pg8::StaticOrder, true, true>(lds, g, S, E, wave);
        }
        SEAM(base + 4);
        if (PH(base + 5)) { PHASE_BEGIN
            const float* hin = (l == 0) ? I_x : I_out;
            const float* wr = I_m_rt + (size_t)(l / 2) * DM * NE;
            for (int m = gw; m < T; m += NGW) {
                f32x4 y[8], hh[8], g[8]; row_load(W_YO + (size_t)m * DM, lane, y); row_load(hin + (size_t)m * DM, lane, hh); row_load(SN_L + DM, lane, g);
                float rstd = rsqrtf(row_ss(y) * (1.0f / DM) + EPS);
#pragma unroll
                for (int j = 0; j < 8; ++j) hh[j] = hh[j] + y[j] * rstd * g[j];
                row_store(I_out + (size_t)m * DM, lane, hh);
                row_load(SN_L + 2 * DM, lane, g);
                rstd = rsqrtf(row_ss(hh) * (1.0f / DM) + EPS);
#pragma unroll
                for (int j = 0; j < 8; ++j) hh[j] = hh[j] * rstd * g[j];
                row_store_bf16(W_XN + (size_t)m * DM, lane, hh);
                if (l & 1) {
                    float lg[8];
#pragma unroll
                    for (int e = 0; e < 8; ++e) lg[e] = 0.f;
#pragma unroll
                    for (int j = 0; j < 8; ++j)
#pragma unroll
                        for (int i = 0; i < 4; ++i) { const int k = 256 * j + 4 * lane + i; const f32x4 w0 = *(const GAS f32x4*)(wr + (size_t)k * 8), w1 = *(const GAS f32x4*)(wr + (size_t)k * 8 + 4); const float c = hh[j][i];
                            lg[0] += c * w0.x; lg[1] += c * w0.y; lg[2] += c * w0.z; lg[3] += c * w0.w; lg[4] += c * w1.x; lg[5] += c * w1.y; lg[6] += c * w1.z; lg[7] += c * w1.w; }
#pragma unroll
                    for (int e = 0; e < 8; ++e) lg[e] = wave_sum(lg[e]);
                    int e0 = 0; float v0 = lg[0];
#pragma unroll
                    for (int e = 1; e < 8; ++e) if (lg[e] > v0) { v0 = lg[e]; e0 = e; }
                    int e1 = -1; float v1 = -__builtin_inff();
#pragma unroll
                    for (int e = 0; e < 8; ++e) if (e != e0 && lg[e] > v1) { v1 = lg[e]; e1 = e; }
                    const float ex = __expf(v1 - v0), g0 = 1.0f / (1.0f + ex), g1 = ex / (1.0f + ex);
                    if (lane == 0) { W_SELE[m] = e0 | (e1 << 8); W_SELG[2 * m] = g0; W_SELG[2 * m + 1] = g1; }
                }
            }
        }
        SEAM(base + 5);
        if ((l & 1) == 0) {
            if (PH(base + 6)) { PHASE_BEGIN
                pg8::Gemm g{W_XN, W_WGU, T, GU, DM}; pg8::StaticOrder S; S.init(T, GU, G, bid);
                pg8::EpiSwiGLU E{W_HB, FF, GU / 256};
                pg8::gemm_phase<pg8::EpiSwiGLU, pg8::StaticOrder, true, true>(lds, g, S, E, wave);
            }
            SEAM(base + 6);
            if (PH(base + 7)) { PHASE_BEGIN
                pg8::Gemm g{W_HB, W_WDN, T, DM, FF}; pg8::StaticOrder S; S.init(T, DM, G, bid);
                pg8::EpiF32P E{W_YO, DM};
                pg8::gemm_phase<pg8::EpiF32P, pg8::StaticOrder, true, true>(lds, g, S, E, wave);
            }
            SEAM(base + 7);
        } else {
            if (PH(base + 8)) { PHASE_BEGIN
                LAS unsigned* wtot = (LAS unsigned*)lds;
                LAS int* posl = (LAS int*)(lds + 1024);
                unsigned cnt[8];
#pragma unroll
                for (int k = 0; k < 8; ++k) cnt[k] = 0u;
                { const GAS v4u* se4 = (const GAS v4u*)(W_SELE + tid * 32);
#pragma unroll
                  for (int j = 0; j < 8; ++j) { const v4u s4 = se4[j];
#pragma unroll
                      for (int q = 0; q < 4; ++q) { const unsigned s = q == 0 ? s4.x : q == 1 ? s4.y : q == 2 ? s4.z : s4.w; const unsigned e0 = s & 255u, e1 = (s >> 8) & 255u;
#pragma unroll
                          for (int k = 0; k < 8; ++k) cnt[k] += (e0 == (unsigned)k ? 1u : 0u) + (e1 == (unsigned)k ? 1u : 0u); } } }
                unsigned inc[8];
#pragma unroll
                for (int k = 0; k < 8; ++k) { unsigned v = cnt[k];
#pragma unroll
                    for (int o = 1; o < 64; o <<= 1) { const unsigned t = __shfl_up(v, o); if (lane >= o) v += t; }
                    inc[k] = v; if (lane == 63) wtot[wave * 8 + k] = v; }
                __syncthreads();
                unsigned excl[8], rowbase[8]; int tbv[9]; tbv[0] = 0;
#pragma unroll
                for (int k = 0; k < 8; ++k) { unsigned before = 0u, total = 0u;
#pragma unroll
                    for (int w = 0; w < 8; ++w) { const unsigned t = wtot[w * 8 + k]; total += t; before += (w < wave) ? t : 0u; }
                    excl[k] = before + inc[k] - cnt[k]; rowbase[k] = (unsigned)tbv[k] * 256u; tbv[k + 1] = tbv[k] + (int)((total + 255u) >> 8); }
                if (bid == 0 && tid == 0) {
#pragma unroll
                    for (int k = 0; k < 9; ++k) W_TBL[k] = tbv[k]; }
                for (int blk = bid; blk < T / 64; blk += G) {
                    if ((tid >> 1) == blk) {
                        const int* se = W_SELE + tid * 32;
                        for (int j = 0; j < 32; ++j) { const unsigned s = (unsigned)se[j]; const unsigned e0 = s & 255u, e1 = (s >> 8) & 255u; unsigned p0 = 0u, p1 = 0u;
#pragma unroll
                            for (int k = 0; k < 8; ++k) { const unsigned here = rowbase[k] + excl[k]; p0 = (e0 == (unsigned)k) ? here : p0; p1 = (e1 == (unsigned)k) ? here : p1; excl[k] += (e0 == (unsigned)k ? 1u : 0u) + (e1 == (unsigned)k ? 1u : 0u); }
                            const int tok = tid * 32 + j; W_POS[2 * tok] = (int)p0; W_POS[2 * tok + 1] = (int)p1; posl[((tid & 1) * 32 + j) * 2] = (int)p0; posl[((tid & 1) * 32 + j) * 2 + 1] = (int)p1; }
                    }
                    __syncthreads();
                    for (int tt = wave; tt < 64; tt += 8) {
                        const int tok = blk * 64 + tt; const int p0 = posl[2 * tt], p1 = posl[2 * tt + 1];
                        const GAS v4u* src = (const GAS v4u*)(W_XN + (size_t)tok * DM); GAS v4u* d0 = (GAS v4u*)(W_XP + (size_t)p0 * DM); GAS v4u* d1 = (GAS v4u*)(W_XP + (size_t)p1 * DM);
#pragma unroll
                        for (int j = 0; j < 4; ++j) { const v4u v = src[lane + 64 * j]; d0[lane + 64 * j] = v; d1[lane + 64 * j] = v; }
                    }
                    __syncthreads();
                }
            }
            SEAM(base + 8);
            if (PH(base + 9)) { PHASE_BEGIN
                pg8::Gemm g{W_XP, W_MGU, MOE_ROWS, GU, DM}; pg8::MoeOrder S; S.init(W_TBL, GU / 256, G, bid);
                pg8::EpiSwiGLU E{W_HB, FF, GU / 256};
                pg8::gemm_phase<pg8::EpiSwiGLU, pg8::MoeOrder, true, true>(lds, g, S, E, wave);
            }
            SEAM(base + 9);
            if (PH(base + 10)) { PHASE_BEGIN
                pg8::Gemm g{W_HB, W_MDN, MOE_ROWS, DM, FF}; pg8::MoeOrder S; S.init(W_TBL, DM / 256, G, bid);
                pg8::EpiF32M E{W_YP, DM, DM / 256};
                pg8::gemm_phase<pg8::EpiF32M, pg8::MoeOrder, true, true>(lds, g, S, E, wave);
            }
            SEAM(base + 10);
        }
        if (PH(base + 30)) { PHASE_BEGIN
            for (int m = gw; m < T; m += NGW) {
                f32x4 y[8], hh[8], g[8];
                if (l & 1) { const int p0 = W_POS[2 * m], p1 = W_POS[2 * m + 1]; const float g0 = W_SELG[2 * m], g1 = W_SELG[2 * m + 1];
                    row_load(W_YP + (size_t)p0 * DM, lane, y); row_load(W_YP + (size_t)p1 * DM, lane, hh);
#pragma unroll
                    for (int j = 0; j < 8; ++j) y[j] = y[j] * g0 + hh[j] * g1; }
                else row_load(W_YO + (size_t)m * DM, lane, y); row_load(I_out + (size_t)m * DM, lane, hh); row_load(SN_L + 3 * DM, lane, g);
                const float rstd = rsqrtf(row_ss(y) * (1.0f / DM) + EPS);
#pragma unroll
                for (int j = 0; j < 8; ++j) hh[j] = hh[j] + y[j] * rstd * g[j];
                row_store(I_out + (size_t)m * DM, lane, hh);
                row_store_bf16(W_XN + (size_t)m * DM, lane, hh);
            }
        }
        SEAM(base + 30);
        if (PH(base + 31)) { PHASE_BEGIN
            pg8::Gemm g{W_XN, W_WPG + (size_t)l * DM * DM, T, DM, DM}; pg8::StaticOrder S; S.init(T, DM, G, bid);
            pg8::EpiPleGate E{W_YO, W_PP, DM};
            pg8::gemm_phase<pg8::EpiPleGate, pg8::StaticOrder, true, true>(lds, g, S, E, wave);
        }
        SEAM(base + 31);
        if (PH(base + 32)) { PHASE_BEGIN
            for (int m = gw; m < T; m += NGW) {
                f32x4 y[8], hh[8], g[8]; row_load(W_YO + (size_t)m * DM, lane, y); row_load(I_out + (size_t)m * DM, lane, hh); row_load(I_p_nm + (size_t)l * DM, lane, g);
                float rstd = rsqrtf(row_ss(y) * (1.0f / DM) + EPS);
#pragma unroll
                for (int j = 0; j < 8; ++j) hh[j] = hh[j] + y[j] * rstd * g[j];
                row_store(I_out + (size_t)m * DM, lane, hh);
                if (l + 1 < DEPTH) {
                    row_load(I_snorm + (size_t)(l + 1) * 4 * DM, lane, g);
                    rstd = rsqrtf(row_ss(hh) * (1.0f / DM) + EPS);
#pragma unroll
                    for (int j = 0; j < 8; ++j) hh[j] = hh[j] * rstd * g[j];
                    row_store_bf16(W_XN + (size_t)m * DM, lane, hh);
                }
            }
        }
        SEAM(base + 32);
    }

__global__ void __launch_bounds__(NWAVES * 64, 2) mk_fwd(Args args) {
    extern __shared__ __attribute__((aligned(16))) unsigned char lds_raw[];
    LAS unsigned char* lds = (LAS unsigned char*)lds_raw;
    volatile LAS unsigned* MISC = (volatile LAS unsigned*)(lds + MISC_OFF);
    const int wave = __builtin_amdgcn_readfirstlane((int)threadIdx.x >> 6);
    const int G = gridDim.x, bid = blockIdx.x;
    gu32* ctl = (gu32*)(args.ws + WS_CTL);
    for (int u = threadIdx.x; u < (LDS_BYTES - RING_BYTES) / 4; u += NWAVES * 64) ((LAS unsigned*)(lds + RING_BYTES))[u] = 0u;
    __syncthreads();
    const int lo = args.ph_lo, hi = args.ph_hi;
    const bool multi = (hi - lo) > 1;
    XcdBarrier bar; bar.bar = (unsigned*)(ctl + CW_BAR); bar.x = 0; bar.st = nullptr; bar.w = wave;
    if (multi) bar = xcd_barrier_post((unsigned*)(ctl + CW_BAR), MISC + 8);

    if (PH(0)) { PHASE_BEGIN
        LAS float* scr = (LAS float*)(lds + wave * 16384);
        int cum = 0;
        for (int l = 0; l < DEPTH; ++l) {
            cvt_matrix(I_w_in + (size_t)l * DM * ZREAL, DM, ZREAL, W_WIN + (size_t)l * ZW * DM, MapIn{}, cum, gw, NGW, scr, lane);
            cvt_matrix(I_w_uq + (size_t)l * QRANK * QW, QRANK, QW, W_WUQ + (size_t)l * QW * QRANK, MapUq{}, cum, gw, NGW, scr, lane);
            cvt_matrix(I_w_ukv + (size_t)l * KVRANK * KVW, KVRANK, KVW, W_WUKV + (size_t)l * KVW * KVRANK, MapId{}, cum, gw, NGW, scr, lane);
            cvt_matrix(I_w_out + (size_t)l * DM * DM, DM, DM, W_WOUT + (size_t)l * DM * DM, MapId{}, cum, gw, NGW, scr, lane);
            cvt_matrix(I_p_wp + (size_t)l * PLE * DM, PLE, DM, W_WPP + (size_t)l * DM * PLE, MapId{}, cum, gw, NGW, scr, lane);
            cvt_matrix(I_p_wg + (size_t)l * DM * DM, DM, DM, W_WPG + (size_t)l * DM * DM, MapId{}, cum, gw, NGW, scr, lane);
        }
        cvt_matrix(I_f_gu, DM, GU, W_WGU, MapGu{}, cum, gw, NGW, scr, lane);
        cvt_matrix(I_f_dn, FF, DM, W_WDN, MapId{}, cum, gw, NGW, scr, lane);
        for (int e = 0; e < NE; ++e) {
            cvt_matrix(I_m_gu + (size_t)e * DM * GU, DM, GU, W_MGU + (size_t)e * GU * DM, MapGu{}, cum, gw, NGW, scr, lane);
            cvt_matrix(I_m_dn + (size_t)e * FF * DM, FF, DM, W_MDN + (size_t)e * DM * FF, MapId{}, cum, gw, NGW, scr, lane);
        }
        for (int i = bid * 512 + tid; i < DEPTH * (ZW - ZREAL) * DM / 8; i += G * 512) {
            const int l = i / ((ZW - ZREAL) * DM / 8), r = i - l * ((ZW - ZREAL) * DM / 8);
            *(GAS v4u*)(W_WIN + (size_t)l * ZW * DM + (size_t)ZREAL * DM + (size_t)r * 8) = (v4u){0u, 0u, 0u, 0u};
        }
        for (int i = bid * 512 + tid; i < T * 32; i += G * 512) {
            const int t = i >> 5, k = i & 31;
            const float inv = 1.0f / powf(10000.0f, (float)(2 * k) / 64.0f);
            const float ang = (float)I_positions[t] * inv;
            const double rev = (double)ang * 0.15915494309189533577;
            const float fr = (float)(rev - floor(rev));
            W_COS[i] = __builtin_amdgcn_cosf(fr); W_SIN[i] = __builtin_amdgcn_sinf(fr);
        }
        for (int i = bid * 512 + tid; i < 1024; i += G * 512) {
            const float a0 = I_lbl[i], a1 = I_lbl[1024 + i], mx = fmaxf(a0, a1), e0 = expf(a0 - mx), e1 = expf(a1 - mx), p0 = e0 / (e0 + e1), p1 = e1 / (e0 + e1);
            W_LB[i] = p0 - p0; W_LB[1024 + i] = (p0 + p1) - p0;
        }
        for (int i = bid * 512 + tid; i < DEPTH * T * PLE / 4; i += G * 512) {
            const f32x4 v = ((const GAS f32x4*)I_pin)[i];
            typedef unsigned u32x2v __attribute__((ext_vector_type(2)));
            u32x2v w; w.x = pk2(v.x, v.y); w.y = pk2(v.z, v.w); ((GAS u32x2v*)W_PB)[i] = w;
        }
        for (int m = gw; m < T; m += NGW) {
            f32x4 v[8], g[8]; row_load(I_x + (size_t)m * DM, lane, v); row_load(I_snorm, lane, g);
            const float rstd = rsqrtf(row_ss(v) * (1.0f / DM) + EPS);
#pragma unroll
            for (int j = 0; j < 8; ++j) v[j] = v[j] * rstd * g[j];
            row_store_bf16(W_XN + (size_t)m * DM, lane, v);
        }
    }
    SEAM(0);

    layer_phases<0>(lo, hi, bar, lds, wave, G, bid);
    layer_phases<1>(lo, hi, bar, lds, wave, G, bid);
#undef PH
#undef SEAM
}

static bool phase_live(int ph) {
    if (ph == 0) return true;
    const int l = (ph - 1) / NPL, k = (ph - 1) % NPL;
    if (k >= 11 && k <= 29) return false;
    if ((l & 1) == 0) return !(k >= 8 && k <= 10);
    return !(k == 6 || k == 7);
}
extern "C" void kernel_launch(void* const* d_in, const int* in_sizes, int n_in, void* d_out, int out_size, void* d_ws, size_t ws_size, hipStream_t stream) {
    static int grid = 0;
    if (grid == 0) {
        if (n_in != 20 || out_size != T * DM || ws_size < WS_END) { fprintf(stderr, "kernel_launch: shape/workspace mismatch (n_in %d out %d ws %zu need %zu)\n", n_in, out_size, ws_size, (size_t)WS_END); grid = -1; return; }
        int dev = 0, cus = 0;
        if (hipGetDevice(&dev) != hipSuccess || hipDeviceGetAttribute(&cus, hipDeviceAttributeMultiprocessorCount, dev) != hipSuccess) { grid = -1; return; }
        if (hipFuncSetAttribute((const void*)mk_fwd, hipFuncAttributeMaxDynamicSharedMemorySize, LDS_BYTES) != hipSuccess) { fprintf(stderr, "kernel_launch: hipFuncSetAttribute failed\n"); grid = -1; return; }
        (void)hipGetLastError();
        grid = cus;
    }
    if (grid < 0) return;
    (void)in_sizes;
    if (hipMemsetAsync((char*)d_ws + WS_CTL, 0, CTL_ZERO_BYTES, stream) != hipSuccess) return;
    Args a{};
    for (int i = 0; i < 20; ++i) a.in[i] = (const float*)d_in[i];
    a.out = (float*)d_out; a.ws = (unsigned char*)d_ws;
#if MK_ONE_LAUNCH
    a.ph_lo = 0; a.ph_hi = NPH;
    hipLaunchKernelGGL(mk_fwd, dim3(grid), dim3(NWAVES * 64), LDS_BYTES, stream, a);
#else
    for (int ph = 0; ph < NPH; ++ph) {
        if (!phase_live(ph)) continue;
        a.ph_lo = ph; a.ph_hi = ph + 1;
        hipLaunchKernelGGL(mk_fwd, dim3(grid), dim3(NWAVES * 64), LDS_BYTES, stream, a);
    }
#endif
}
```

```cpp
#include <hip/hip_runtime.h>
#include <cstdio>
#include <cstdint>
#ifndef MK_ONE_LAUNCH
#define MK_ONE_LAUNCH 1
#endif
__device__ __forceinline__ int hw_lane() { int l; asm volatile("v_mbcnt_lo_u32_b32 %0, -1, 0\n\tv_mbcnt_hi_u32_b32 %0, -1, %0" : "=v"(l)); return l; }
namespace pg8 {
#define PG8_LAS __attribute__((address_space(3)))
typedef unsigned short bf16_t;
typedef short bf16x8 __attribute__((ext_vector_type(8)));
typedef float f32x4 __attribute__((ext_vector_type(4)));
typedef unsigned u32x4 __attribute__((ext_vector_type(4)));
constexpr int BM = 256, BK = 64, HALF = 128, HTB = HALF * BK * 2  , STAGE_BYTES = 8 * HTB, NXCD = 8, WGM = 8;

__host__ __device__ __forceinline__ int lds_byte(int r, int c) { const int st = (r >> 4) * 2 + (c >> 5), rr = r & 15, cc = c & 31, ob = rr * 64 + cc * 2; return st * 1024 + (ob ^ (((ob >> 9) & 1) << 5)); }
__host__ __device__ __forceinline__ void stage_rc(int b, int& R, int& C) { const int st = b / 1024, sb = b % 1024, swz = sb ^ (((sb >> 9) & 1) << 5); R = (st >> 1) * 16 + swz / 64; C = (st & 1) * 32 + (swz % 64) / 2; }
__host__ __device__ __forceinline__ int perm32(int rho) { const int n = rho >> 4, i = rho & 15; return 8 * (i >> 2) + 4 * n + (i & 3); }

struct Unit { int pm, pn; };
struct Gemm { const bf16_t* A; const bf16_t* Bt; int M, N, K; };

struct StaticOrder {
    int nM, nN, nwg, G, c;
    __host__ __device__ void init(int M, int N, int G_, int c_) { nM = M / BM; nN = N / BM; nwg = nM * nN; G = G_; c = c_; }
    __host__ __device__ bool next(int i, Unit& u) const {
        const long L = (long)i * G + c; if (L >= nwg) return false;
        int wgid = (int)L; { const int q = nwg / NXCD, r = nwg % NXCD, xcd = wgid % NXCD, off = wgid / NXCD; wgid = (xcd < r ? xcd * (q + 1) : r * (q + 1) + (xcd - r) * q) + off; }
        const int nig = WGM * nN, gid = wgid / nig, fm = gid * WGM, gsz = (nM - fm) < WGM ? (nM - fm) : WGM;
        u.pm = fm + ((wgid % nig) % gsz); u.pn = (wgid % nig) / gsz; return true;
    }
    __device__ __forceinline__ void a_ready(const Unit&) const {}
    __device__ __forceinline__ void done(const Unit&) const {}
};

__device__ __forceinline__ unsigned cvt_pk_bf16(float lo, float hi) { unsigned r; asm volatile("v_cvt_pk_bf16_f32 %0, %1, %2" : "=v"(r) : "v"(lo), "v"(hi)); return r; }
typedef float f32x2 __attribute__((ext_vector_type(2)));

template <class Epi, class Sched, bool ALIGN_EPI = false, bool SP2 = false>
__device__ __forceinline__ void gemm_phase(PG8_LAS unsigned char* lds, const Gemm g, const Sched& S, const Epi& E, const int wid) {
    const int lane = hw_lane(), tid = wid * 64 + lane, wr = wid >> 2, wc = wid & 3, fr = lane & 15, fq = lane >> 4;
    int K = g.K; asm volatile("" : "+s"(K));
    const int nt = K / BK;
    unsigned voffA[2], voffB[2];
#pragma unroll
    for (int i = 0; i < 2; ++i) { int R, C; stage_rc(tid * 16 + i * 8192, R, C); const int Rb = Epi::PERM ? ((R & ~31) + perm32(R & 31)) : R;
        voffA[i] = (unsigned)(R * K + C) * 2u; voffB[i] = (unsigned)(Rb * K + C) * 2u; }
    const size_t kstep = (size_t)(BK * 2);
    const size_t hstep = (size_t)HALF * K * 2;
    const size_t tstep = 2 * hstep;
    const unsigned ldsw = (unsigned)wid * 1024u;
    const int aoff = lds_byte(wr * 64 + fr, fq * 8), boff = lds_byte(wc * 32 + fr, fq * 8);
#define PG8_SA(b, h) (((b) * 2 + (h)) * HTB)
#define PG8_SB(b, h) ((4 + (b) * 2 + (h)) * HTB)
#define PG8_STAGE(bufoff, gbase, voff) do { _Pragma("unroll") for (int _i = 0; _i < 2; ++_i) \
        __builtin_amdgcn_global_load_lds((const unsigned*)((const char*)(gbase) + (voff)[_i]), (PG8_LAS unsigned*)(lds + (bufoff) + ldsw + _i * 8192), 16, 0, 0); } while (0)
#define PG8_LDA(dst, b, h) do { _Pragma("unroll") for (int m = 0; m < 4; ++m) _Pragma("unroll") for (int k = 0; k < 2; ++k) dst[m][k] = *(const PG8_LAS bf16x8*)(lds + PG8_SA(b, h) + aoff + m * 2048 + k * 1024); } while (0)
#define PG8_LDB(dst, b, h) do { _Pragma("unroll") for (int n = 0; n < 2; ++n) _Pragma("unroll") for (int k = 0; k < 2; ++k) dst[n][k] = *(const PG8_LAS bf16x8*)(lds + PG8_SB(b, h) + boff + n * 2048 + k * 1024); } while (0)
#define PG8_MMA(ai, bj, At, Bt) do { __builtin_amdgcn_s_setprio(1); _Pragma("unroll") for (int m = 0; m < 4; ++m) _Pragma("unroll") for (int n = 0; n < 2; ++n) _Pragma("unroll") for (int k = 0; k < 2; ++k) \
        acc[ai][bj][m][n] = __builtin_amdgcn_mfma_f32_16x16x32_bf16(Bt[n][k], At[m][k], acc[ai][bj][m][n], 0, 0, 0); __builtin_amdgcn_s_setprio(0); } while (0)
#define PG8_WAIT_V(n) asm volatile("s_waitcnt vmcnt(" #n ")" ::: "memory")
#define PG8_WAIT_L(n) asm volatile("s_waitcnt lgkmcnt(" #n ")" ::: "memory")
#define PG8_BAR __builtin_amdgcn_s_barrier()
#define PG8_SCHED __builtin_amdgcn_sched_barrier(0)
    Unit cur, nxt; int ui = 0;
    if (!S.next(0, cur)) return;
    f32x4 acc[2][2][4][2];
#pragma unroll
    for (int a = 0; a < 2; ++a)
#pragma unroll
        for (int b = 0; b < 2; ++b)
#pragma unroll
            for (int m = 0; m < 4; ++m)
#pragma unroll
                for (int n = 0; n < 2; ++n) acc[a][b][m][n] = (f32x4){0.f, 0.f, 0.f, 0.f};
    bf16x8 At[4][2], B0[2][2], B1[2][2];
    const char* cA = (const char*)g.A + (size_t)cur.pm * tstep; const char* cB = (const char*)g.Bt + (size_t)cur.pn * tstep;
    S.a_ready(cur);
    if constexpr (SP2) {
        PG8_STAGE(PG8_SB(0, 0), cB, voffB); PG8_STAGE(PG8_SB(0, 1), cB + hstep, voffB); PG8_STAGE(PG8_SA(0, 0), cA, voffA); PG8_STAGE(PG8_SA(0, 1), cA + hstep, voffA);
        if (wr == 1) PG8_BAR;
        PG8_WAIT_V(2); PG8_BAR;
        PG8_STAGE(PG8_SB(1, 0), cB + kstep, voffB); PG8_STAGE(PG8_SA(1, 0), cA + kstep, voffA); PG8_STAGE(PG8_SB(1, 1), cB + hstep + kstep, voffB);
        PG8_WAIT_V(6); PG8_BAR;
    } else {
        PG8_STAGE(PG8_SB(0, 0), cB, voffB); PG8_STAGE(PG8_SA(0, 0), cA, voffA); PG8_STAGE(PG8_SB(0, 1), cB + hstep, voffB); PG8_STAGE(PG8_SA(0, 1), cA + hstep, voffA);
        if (wr == 1) PG8_BAR;
        PG8_WAIT_V(4); PG8_BAR;
        PG8_STAGE(PG8_SB(1, 0), cB + kstep, voffB); PG8_STAGE(PG8_SA(1, 0), cA + kstep, voffA); PG8_STAGE(PG8_SB(1, 1), cB + hstep + kstep, voffB);
        PG8_WAIT_V(6); PG8_BAR;
    }
    for (;;) {
        const bool has_next = S.next(ui + 1, nxt);
        const char* nA = has_next ? (const char*)g.A + (size_t)nxt.pm * tstep : cA; const char* nB = has_next ? (const char*)g.Bt + (size_t)nxt.pn * tstep : cB;
        for (int t = 0; t < nt; t += 2) {
            const bool last = (t == nt - 2);
            const char* a1 = cA + (size_t)(t + 1) * kstep;
            const char* a2 = last ? nA : cA + (size_t)(t + 2) * kstep; const char* b2 = last ? nB : cB + (size_t)(t + 2) * kstep;
            const char* a3 = a2 + kstep; const char* b3 = b2 + kstep;
            if (last && has_next) S.a_ready(nxt);
            if constexpr (SP2) {
            PG8_LDB(B0, 0, 0); PG8_LDB(B1, 0, 1); PG8_SCHED; PG8_LDA(At, 0, 0); PG8_STAGE(PG8_SA(1, 1), a1 + hstep, voffA);
            PG8_WAIT_V(8); PG8_WAIT_L(0); PG8_BAR; PG8_MMA(0, 0, At, B0); PG8_MMA(0, 1, At, B1); PG8_BAR; PG8_SCHED;
            PG8_LDA(At, 0, 1); PG8_STAGE(PG8_SB(0, 0), b2, voffB); PG8_STAGE(PG8_SB(0, 1), b2 + hstep, voffB); PG8_STAGE(PG8_SA(0, 0), a2, voffA);
            PG8_WAIT_V(8); PG8_WAIT_L(0); PG8_BAR; PG8_MMA(1, 0, At, B0); PG8_MMA(1, 1, At, B1); PG8_BAR; PG8_SCHED;
            PG8_LDB(B0, 1, 0); PG8_LDB(B1, 1, 1); PG8_SCHED; PG8_LDA(At, 1, 0); PG8_STAGE(PG8_SA(0, 1), a2 + hstep, voffA);
            PG8_WAIT_V(8); PG8_WAIT_L(0); PG8_BAR; PG8_MMA(0, 0, At, B0); PG8_MMA(0, 1, At, B1); PG8_BAR; PG8_SCHED;
            PG8_LDA(At, 1, 1); PG8_STAGE(PG8_SB(1, 0), b3, voffB); PG8_STAGE(PG8_SB(1, 1), b3 + hstep, voffB); PG8_STAGE(PG8_SA(1, 0), a3, voffA);
            PG8_WAIT_V(8); PG8_WAIT_L(0); PG8_BAR; PG8_MMA(1, 0, At, B0); PG8_MMA(1, 1, At, B1); PG8_BAR; PG8_SCHED;
            } else {
            PG8_LDB(B0, 0, 0); PG8_SCHED; PG8_LDA(At, 0, 0); PG8_STAGE(PG8_SA(1, 1), a1 + hstep, voffA);
            PG8_WAIT_L(8); PG8_BAR; PG8_WAIT_L(0); PG8_MMA(0, 0, At, B0); PG8_BAR; PG8_SCHED;
            PG8_LDB(B1, 0, 1); PG8_STAGE(PG8_SB(0, 0), b2, voffB);
            PG8_BAR; PG8_WAIT_L(0); PG8_MMA(0, 1, At, B1); PG8_BAR;
            PG8_LDA(At, 0, 1); PG8_STAGE(PG8_SA(0, 0), a2, voffA);
            PG8_BAR; PG8_WAIT_L(0); PG8_MMA(1, 0, At, B0); PG8_BAR; PG8_SCHED;
            PG8_STAGE(PG8_SB(0, 1), b2 + hstep, voffB);
            PG8_WAIT_V(6); PG8_BAR; PG8_MMA(1, 1, At, B1); PG8_BAR;
            PG8_LDB(B0, 1, 0); PG8_SCHED; PG8_LDA(At, 1, 0); PG8_STAGE(PG8_SA(0, 1), a2 + hstep, voffA);
            PG8_WAIT_L(8); PG8_BAR; PG8_WAIT_L(0); PG8_MMA(0, 0, At, B0); PG8_BAR; PG8_SCHED;
            PG8_LDB(B1, 1, 1); PG8_STAGE(PG8_SB(1, 0), b3, voffB);
            PG8_BAR; PG8_WAIT_L(0); PG8_MMA(0, 1, At, B1); PG8_BAR;
            PG8_LDA(At, 1, 1); PG8_STAGE(PG8_SA(1, 0), a3, voffA);
            PG8_BAR; PG8_WAIT_L(0); PG8_MMA(1, 0, At, B0); PG8_BAR; PG8_SCHED;
            PG8_STAGE(PG8_SB(1, 1), b3 + hstep, voffB);
            PG8_WAIT_V(6); PG8_BAR; PG8_MMA(1, 1, At, B1); PG8_BAR;
            }
        }
        if constexpr (ALIGN_EPI) { if (wr == 0) PG8_BAR; }
        if constexpr (!Epi::AFTER_DRAIN) { const int l2 = hw_lane(); E(acc, cur, wr, wc, l2 & 15, l2 >> 4); S.done(cur); }
        if (!has_next) break;
#pragma unroll
        for (int a = 0; a < 2; ++a)
#pragma unroll
            for (int b = 0; b < 2; ++b)
#pragma unroll
                for (int m = 0; m < 4; ++m)
#pragma unroll
                    for (int n = 0; n < 2; ++n) acc[a][b][m][n] = (f32x4){0.f, 0.f, 0.f, 0.f};
        cur = nxt; cA = nA; cB = nB; ++ui;
        if constexpr (ALIGN_EPI) { if (wr == 1) PG8_BAR; }
    }
    PG8_WAIT_V(0);
    if constexpr (!ALIGN_EPI) { if (wr == 0) PG8_BAR; }
    PG8_BAR;
    if constexpr (Epi::AFTER_DRAIN) { E.fused(acc, cur, wr, wc, fr, fq, lds, wid, lane); S.done(cur); }
#undef PG8_SA
#undef PG8_SB
#undef PG8_STAGE
#undef PG8_LDA
#undef PG8_LDB
#undef PG8_MMA
#undef PG8_WAIT_V
#undef PG8_WAIT_L
#undef PG8_BAR
#undef PG8_SCHED
}
}
#define GAS __attribute__((address_space(1)))
#define LAS __attribute__((address_space(3)))
typedef unsigned short bf16;
typedef unsigned v4u __attribute__((ext_vector_type(4)));
typedef float f32x4 __attribute__((ext_vector_type(4)));
typedef short bf16x8 __attribute__((ext_vector_type(8)));
typedef GAS unsigned gu32;
typedef GAS unsigned long long gu64;
#define RLX_AGENT __ATOMIC_RELAXED, __HIP_MEMORY_SCOPE_AGENT
#define LDS_WAIT() asm volatile("s_waitcnt lgkmcnt(0)" ::: "memory")
#define VM_WAIT() asm volatile("s_waitcnt vmcnt(0)" ::: "memory")
__device__ __forceinline__ unsigned long long rt() { return __builtin_amdgcn_s_memrealtime(); }
__device__ __forceinline__ unsigned f2bf(float f) { unsigned u = __builtin_bit_cast(unsigned, f); return (u + 0x7fffu + ((u >> 16) & 1u)) >> 16; }
__device__ __forceinline__ unsigned pk2(float lo, float hi) { return f2bf(lo) | (f2bf(hi) << 16); }

#define XB_TMO      128
#define XB_XCNT(j)  (256  + 64 * (j))
#define XB_XSUB(j)  (1280 + 64 * (j))
#define XB_XGEN(j)  (2304 + 64 * (j))
#define XB_TOP      3328
#define XB_TOPGEN   3392
#define XCD_BAR_WORDS 3456
#define XB_SPIN_CAP (1u << 18)

__device__ __forceinline__ unsigned xb_ld(unsigned* p)              { return __hip_atomic_load(p, __ATOMIC_RELAXED, __HIP_MEMORY_SCOPE_AGENT); }
__device__ __forceinline__ unsigned xb_add(unsigned* p, unsigned v) { return __hip_atomic_fetch_add(p, v, __ATOMIC_RELAXED, __HIP_MEMORY_SCOPE_AGENT); }
__device__ __forceinline__ unsigned xb_xcc_id() { return (unsigned)__builtin_amdgcn_s_getreg((3 << 11) | 20) & 0xFu; }
#define XB_SPIN(cond, bar) do { unsigned _sp = 0; while (cond) { __builtin_amdgcn_s_sleep(1); \
    if ((++_sp & 255u) == 0u) { if (xb_ld(&(bar)[XB_TMO])) break; if (_sp > XB_SPIN_CAP) { atomicAdd(&(bar)[XB_TMO], 1u); break; } } } } while (0)

struct XcdBarrier {
    unsigned* bar; unsigned x;
    int w;
    volatile LAS unsigned* st;
};

__device__ __forceinline__ XcdBarrier xcd_barrier_post(unsigned* bar, volatile LAS unsigned* st) {
    XcdBarrier b; b.bar = bar; b.x = xb_xcc_id(); b.st = st; b.w = __builtin_amdgcn_readfirstlane((int)threadIdx.x >> 6);
    if (threadIdx.x == 0) (void)xb_add(&bar[XB_XCNT(b.x)], 1u);
    return b;
}
__device__ __forceinline__ void xcd_barrier_complete(unsigned* bar, unsigned x, unsigned& nloc, unsigned& nx) {
    const unsigned G = gridDim.x * gridDim.y * gridDim.z;
    unsigned sum, cnt, mine, sp = 0u;
    for (;;) {
        sum = 0u; cnt = 0u; mine = 0u;
#pragma unroll
        for (unsigned j = 0; j < 16; ++j) { const unsigned c = xb_ld(&bar[XB_XCNT(j)]); sum += c; cnt += (c > 0u) ? 1u : 0u; mine = (j == x) ? c : mine; }
        if (sum == G) break;
        __builtin_amdgcn_s_sleep(1);
        if ((++sp & 255u) == 0u) { if (xb_ld(&bar[XB_TMO])) break; if (sp > XB_SPIN_CAP) { atomicAdd(&bar[XB_TMO], 1u); break; } }
    }
    nloc = mine > 0u ? mine : 1u; nx = cnt > 0u ? cnt : 1u;
}

__device__ __forceinline__ void xcd_barrier(const XcdBarrier& b) {
    asm volatile("s_waitcnt vmcnt(0)" ::: "memory");
    __syncthreads();
    if (b.w == 0 && hw_lane() == 0) {
        unsigned* bar = b.bar;
        __builtin_amdgcn_s_waitcnt(0);
        unsigned nloc = b.st[0], nx = b.st[1];
        if (nloc == 0u) { xcd_barrier_complete(bar, b.x, nloc, nx); b.st[0] = nloc; b.st[1] = nx; }
        const unsigned old = xb_add(&bar[XB_XSUB(b.x)], 1u);
        const unsigned gen = old / nloc;
        if (old + 1u == (gen + 1u) * nloc) {
            __builtin_amdgcn_fence(__ATOMIC_RELEASE, "agent");
            asm volatile("s_waitcnt vmcnt(0)" ::: "memory");
            const unsigned og = xb_add(&bar[XB_TOP], 1u);
            const unsigned tg = og / nx;
            if (og + 1u == (tg + 1u) * nx) xb_add(&bar[XB_TOPGEN], 1u);
            else XB_SPIN(xb_ld(&bar[XB_TOPGEN]) == tg, bar);
            __builtin_amdgcn_fence(__ATOMIC_ACQUIRE, "agent");
            xb_add(&bar[XB_XGEN(b.x)], 1u);
            asm volatile("s_waitcnt vmcnt(0)" ::: "memory");
        } else {
            XB_SPIN(xb_ld(&bar[XB_XGEN(b.x)]) == gen, bar);
            __builtin_amdgcn_fence(__ATOMIC_ACQUIRE, "agent");
            asm volatile("s_waitcnt vmcnt(0)" ::: "memory");
        }
    }
    __syncthreads();
}

namespace pg8 {
struct EpiBf16P {
    static constexpr bool PERM = true, AFTER_DRAIN = false;
    bf16_t* O; int ldc;
    __device__ __forceinline__ void operator()(const f32x4 (&acc)[2][2][4][2], const Unit& u, int wr, int wc, int fr, int fq) const {
        const int row0 = u.pm * BM + wr * 64 + fr, col0 = u.pn * BM + wc * 32 + 8 * fq;
#pragma unroll
        for (int ai = 0; ai < 2; ++ai)
#pragma unroll
            for (int m = 0; m < 4; ++m) { bf16_t* rowp = O + (size_t)(row0 + ai * HALF + m * 16) * ldc + col0;
#pragma unroll
                for (int bj = 0; bj < 2; ++bj) { const f32x4 v0 = acc[ai][bj][m][0], v1 = acc[ai][bj][m][1];
                    u32x4 w; w.x = cvt_pk_bf16(v0[0], v0[1]); w.y = cvt_pk_bf16(v0[2], v0[3]); w.z = cvt_pk_bf16(v1[0], v1[1]); w.w = cvt_pk_bf16(v1[2], v1[3]);
                    *(u32x4*)(rowp + bj * HALF) = w; } }
    }
};
struct EpiQRope {
    static constexpr bool PERM = true, AFTER_DRAIN = false;
    bf16_t* O; int ldc; const float* cosT; const float* sinT; float scale;
    __device__ __forceinline__ void operator()(const f32x4 (&acc)[2][2][4][2], const Unit& u, int wr, int wc, int fr, int fq) const {
        const int row0 = u.pm * BM + wr * 64 + fr, col0 = u.pn * BM + wc * 32 + 8 * fq;
#pragma unroll
        for (int ai = 0; ai < 2; ++ai)
#pragma unroll
            for (int m = 0; m < 4; ++m) { const int row = row0 + ai * HALF + m * 16; bf16_t* rowp = O + (size_t)row * ldc + col0;
#pragma unroll
                for (int bj = 0; bj < 2; ++bj) { f32x4 v0 = acc[ai][bj][m][0], v1 = acc[ai][bj][m][1];
                    const int hc = (col0 + bj * HALF) % 192;
                    if (hc >= 128) { const int i0 = (hc - 128) >> 1;
                        const f32x4 c4 = *(const f32x4*)(cosT + (size_t)row * 32 + i0), s4 = *(const f32x4*)(sinT + (size_t)row * 32 + i0);
                        f32x4 r0, r1;
                        r0[0] = v0[0] * c4[0] - v0[1] * s4[0]; r0[1] = v0[1] * c4[0] + v0[0] * s4[0];
                        r0[2] = v0[2] * c4[1] - v0[3] * s4[1]; r0[3] = v0[3] * c4[1] + v0[2] * s4[1];
                        r1[0] = v1[0] * c4[2] - v1[1] * s4[2]; r1[1] = v1[1] * c4[2] + v1[0] * s4[2];
                        r1[2] = v1[2] * c4[3] - v1[3] * s4[3]; r1[3] = v1[3] * c4[3] + v1[2] * s4[3];
                        v0 = r0; v1 = r1; }
                    v0 = v0 * scale; v1 = v1 * scale;
                    u32x4 w; w.x = cvt_pk_bf16(v0[0], v0[1]); w.y = cvt_pk_bf16(v0[2], v0[3]); w.z = cvt_pk_bf16(v1[0], v1[1]); w.w = cvt_pk_bf16(v1[2], v1[3]);
                    *(u32x4*)(rowp + bj * HALF) = w; } }
    }
};
struct EpiKV {
    static constexpr bool PERM = true, AFTER_DRAIN = false;
    bf16_t* K192; bf16_t* V;
    __device__ __forceinline__ void operator()(const f32x4 (&acc)[2][2][4][2], const Unit& u, int wr, int wc, int fr, int fq) const {
        const int row0 = u.pm * BM + wr * 64 + fr, c0 = wc * 32 + 8 * fq;
#pragma unroll
        for (int ai = 0; ai < 2; ++ai)
#pragma unroll
            for (int m = 0; m < 4; ++m) { const size_t row = (size_t)(row0 + ai * HALF + m * 16);
#pragma unroll
                for (int bj = 0; bj < 2; ++bj) { const f32x4 v0 = acc[ai][bj][m][0], v1 = acc[ai][bj][m][1];
                    u32x4 w; w.x = cvt_pk_bf16(v0[0], v0[1]); w.y = cvt_pk_bf16(v0[2], v0[3]); w.z = cvt_pk_bf16(v1[0], v1[1]); w.w = cvt_pk_bf16(v1[2], v1[3]);
                    bf16_t* dst = bj == 0 ? K192 + (row * 8 + u.pn) * 192 + c0 : V + (row * 8 + u.pn) * 128 + c0;
                    *(u32x4*)dst = w; } }
    }
};
struct EpiF32P {
    static constexpr bool PERM = false, AFTER_DRAIN = false;
    float* C; int ldc;
    __device__ __forceinline__ void operator()(const f32x4 (&acc)[2][2][4][2], const Unit& u, int wr, int wc, int fr, int fq) const {
        const int row0 = u.pm * BM + wr * 64 + fr, col0 = u.pn * BM + wc * 32 + 4 * fq;
#pragma unroll
        for (int ai = 0; ai < 2; ++ai)
#pragma unroll
            for (int m = 0; m < 4; ++m) { float* rowp = C + (size_t)(row0 + ai * HALF + m * 16) * ldc + col0;
#pragma unroll
                for (int bj = 0; bj < 2; ++bj)
#pragma unroll
                    for (int n = 0; n < 2; ++n) *(f32x4*)(rowp + bj * HALF + n * 16) = acc[ai][bj][m][n]; }
    }
};
struct EpiSwiGLU {
    static constexpr bool PERM = false, AFTER_DRAIN = false;
    bf16_t* H; int ldh; int npn;
    __device__ __forceinline__ void operator()(const f32x4 (&acc)[2][2][4][2], const Unit& u, int wr, int wc, int fr, int fq) const {
        const int row0 = u.pm * BM + wr * 64 + fr, j0 = (u.pn % npn) * 128 + wc * 16 + 4 * fq;
#pragma unroll
        for (int ai = 0; ai < 2; ++ai)
#pragma unroll
            for (int m = 0; m < 4; ++m) { bf16_t* rowp = H + (size_t)(row0 + ai * HALF + m * 16) * ldh + j0;
#pragma unroll
                for (int bj = 0; bj < 2; ++bj) { const f32x4 g = acc[ai][bj][m][0], uu = acc[ai][bj][m][1]; f32x4 h;
#pragma unroll
                    for (int i = 0; i < 4; ++i) h[i] = g[i] * __builtin_amdgcn_rcpf(1.0f + __builtin_amdgcn_exp2f(-1.4426950408889634f * g[i])) * uu[i];
                    typedef unsigned u32x2v __attribute__((ext_vector_type(2)));
                    u32x2v w; w.x = cvt_pk_bf16(h[0], h[1]); w.y = cvt_pk_bf16(h[2], h[3]);
                    *(u32x2v*)(rowp + bj * 64) = w; } }
    }
};
struct EpiPleGate {
    static constexpr bool PERM = false, AFTER_DRAIN = false;
    float* R; const float* P; int ldc;
    __device__ __forceinline__ void operator()(const f32x4 (&acc)[2][2][4][2], const Unit& u, int wr, int wc, int fr, int fq) const {
        const int row0 = u.pm * BM + wr * 64 + fr, col0 = u.pn * BM + wc * 32 + 4 * fq;
#pragma unroll
        for (int ai = 0; ai < 2; ++ai)
#pragma unroll
            for (int m = 0; m < 4; ++m) { const size_t off = (size_t)(row0 + ai * HALF + m * 16) * ldc + col0;
#pragma unroll
                for (int bj = 0; bj < 2; ++bj)
#pragma unroll
                    for (int n = 0; n < 2; ++n) { const f32x4 a = acc[ai][bj][m][n], p = *(const f32x4*)(P + off + bj * HALF + n * 16); f32x4 r;
#pragma unroll
                        for (int i = 0; i < 4; ++i) r[i] = p[i] * __builtin_amdgcn_rcpf(1.0f + __builtin_amdgcn_exp2f(-1.4426950408889634f * a[i]));
                        *(f32x4*)(R + off + bj * HALF + n * 16) = r; } }
    }
};
struct MoeOrder {
    int nM, nN, nwg, G, c; int tb1, tb2, tb3, tb4, tb5, tb6, tb7;
    __device__ __forceinline__ void init(const int* tbl, int nN_, int G_, int c_) { nM = tbl[8]; nN = nN_; nwg = nM * nN; G = G_; c = c_; tb1 = tbl[1]; tb2 = tbl[2]; tb3 = tbl[3]; tb4 = tbl[4]; tb5 = tbl[5]; tb6 = tbl[6]; tb7 = tbl[7]; }
    __device__ __forceinline__ bool next(int i, Unit& u) const {
        const long L = (long)i * G + c; if (L >= nwg) return false;
        int wgid = (int)L; { const int q = nwg / NXCD, r = nwg % NXCD, xcd = wgid % NXCD, off = wgid / NXCD; wgid = (xcd < r ? xcd * (q + 1) : r * (q + 1) + (xcd - r) * q) + off; }
        const int nig = WGM * nN, gid = wgid / nig, fm = gid * WGM, gsz = (nM - fm) < WGM ? (nM - fm) : WGM;
        const int pm = fm + ((wgid % nig) % gsz), pn = (wgid % nig) / gsz;
        const int e = (pm >= tb1) + (pm >= tb2) + (pm >= tb3) + (pm >= tb4) + (pm >= tb5) + (pm >= tb6) + (pm >= tb7);
        u.pm = pm; u.pn = e * nN + pn; return true;
    }
    __device__ __forceinline__ void a_ready(const Unit&) const {}
    __device__ __forceinline__ void done(const Unit&) const {}
};
struct EpiF32M {
    static constexpr bool PERM = false, AFTER_DRAIN = false;
    float* C; int ldc; int npn;
    __device__ __forceinline__ void operator()(const f32x4 (&acc)[2][2][4][2], const Unit& u, int wr, int wc, int fr, int fq) const {
        const int row0 = u.pm * BM + wr * 64 + fr, col0 = (u.pn % npn) * BM + wc * 32 + 4 * fq;
#pragma unroll
        for (int ai = 0; ai < 2; ++ai)
#pragma unroll
            for (int m = 0; m < 4; ++m) { float* rowp = C + (size_t)(row0 + ai * HALF + m * 16) * ldc + col0;
#pragma unroll
                for (int bj = 0; bj < 2; ++bj)
#pragma unroll
                    for (int n = 0; n < 2; ++n) *(f32x4*)(rowp + bj * HALF + n * 16) = acc[ai][bj][m][n]; }
    }
};
}

constexpr int T = 16384, DM = 2048, SEQ = 4096, NBATCH = 4, DEPTH = 2;
constexpr int ZW = 4864, ZREAL = 4800;
constexpr int CQ0 = 0, CKV0 = 384, KR0 = 640, HQ0 = 704, HF0 = 1728, HI0 = 2752, HG0 = 3776;
constexpr int QRANK = 384, KVRANK = 256, NH = 8, DQK = 192, QW = 1536, KVW = 2048;
constexpr int FF = 7168, GU = 14336, NE = 8, PLE = 256;
constexpr float EPS = 1e-6f;
constexpr float QSCALE = 0.07216878364870322f * 1.4426950408889634f;
constexpr int NWAVES = 8;
constexpr int LDS_BYTES = 147456;
constexpr int RING_BYTES = 131072;
constexpr int MISC_OFF = RING_BYTES + 320;

constexpr size_t MiB = 1ull << 20;
constexpr size_t rup(size_t x) { return (x + MiB - 1) & ~(MiB - 1); }
constexpr size_t WS_CTL = 0, CTL_ZERO_BYTES = 1 * MiB;
constexpr size_t WS_LB   = 1 * MiB;
constexpr size_t WS_COS  = 2 * MiB;
constexpr size_t WS_SIN  = 4 * MiB;
constexpr size_t WS_SELE = 6 * MiB;
constexpr size_t WS_SELG = 7 * MiB;
constexpr size_t WS_WIN  = 8 * MiB;
constexpr size_t WS_WUQ  = WS_WIN  + rup(2ull * ZW * DM * 2);
constexpr size_t WS_WUKV = WS_WUQ  + rup(2ull * QW * QRANK * 2);
constexpr size_t WS_WOUT = WS_WUKV + rup(2ull * KVW * KVRANK * 2);
constexpr size_t WS_WGU  = WS_WOUT + rup(2ull * DM * DM * 2);
constexpr size_t WS_WDN  = WS_WGU  + rup(1ull * GU * DM * 2);
constexpr size_t WS_MGU  = WS_WDN  + rup(1ull * DM * FF * 2);
constexpr size_t WS_MDN  = WS_MGU  + rup(8ull * GU * DM * 2);
constexpr size_t WS_WPP  = WS_MDN  + rup(8ull * DM * FF * 2);
constexpr size_t WS_WPG  = WS_WPP  + rup(2ull * DM * PLE * 2);
constexpr size_t WS_XN   = WS_WPG  + rup(2ull * DM * DM * 2);
constexpr size_t WS_Z    = WS_XN   + rup(1ull * T * DM * 2);
constexpr size_t WS_CQ   = WS_Z    + rup(1ull * T * ZW * 2);
constexpr size_t WS_CKV  = WS_CQ   + rup(1ull * T * QRANK * 2);
constexpr size_t WS_KPE  = WS_CKV  + rup(1ull * T * KVRANK * 2);
constexpr size_t WS_Q    = WS_KPE  + rup(1ull * T * 64 * 2);
constexpr size_t WS_K192 = WS_Q    + rup(1ull * T * QW * 2);
constexpr size_t WS_V    = WS_K192 + rup(1ull * T * QW * 2);
constexpr size_t WS_Y    = WS_V    + rup(1ull * T * 1024 * 2);
constexpr size_t WS_YO   = WS_Y    + rup(1ull * T * DM * 2);
constexpr size_t WS_PP   = WS_YO   + rup(1ull * T * DM * 4);
constexpr size_t WS_PB   = WS_PP   + rup(1ull * T * DM * 4);
constexpr int    MOE_ROWS = 34816;
constexpr size_t WS_POS  = WS_PB   + rup(2ull * T * PLE * 2);
constexpr size_t WS_TBL  = WS_POS  + rup(1ull * T * 8);
constexpr size_t WS_XP   = WS_TBL  + MiB;
constexpr size_t WS_YP   = WS_XP   + rup(1ull * MOE_ROWS * DM * 2);
constexpr size_t WS_HB   = WS_YP   + rup(1ull * MOE_ROWS * DM * 4);
constexpr size_t WS_END  = WS_HB   + rup(1ull * MOE_ROWS * FF * 2);

constexpr int CW_BAR = 4096;


namespace att {
typedef float f32x16 __attribute__((ext_vector_type(16)));
typedef short s16x4 __attribute__((ext_vector_type(4)));
typedef short b16x8 __attribute__((ext_vector_type(8)));
typedef unsigned u32x4v __attribute__((ext_vector_type(4)));
constexpr int KT = 64 * 384, VT = 64 * 256;
constexpr int LDS_V = 0, LDS_K = 2 * VT, LDS_WS = 2 * VT + 2 * KT, LDS_TOTAL = LDS_WS + 8 * 64 * 4;
constexpr float THR2 = 11.5415603f;
#define ATT_SBAR() __builtin_amdgcn_sched_barrier(0)
__device__ __forceinline__ int crow(int r, int hi) { return (r & 3) + 8 * (r >> 2) + 4 * hi; }
__device__ __forceinline__ unsigned cvtpk(float lo, float hi) { unsigned r; asm volatile("v_cvt_pk_bf16_f32 %0, %1, %2" : "=v"(r) : "v"(lo), "v"(hi)); return r; }
__device__ __forceinline__ int ksw(int key) { return ((key >> 1) & 3) | (((key >> 4) & 1) << 2); }
__device__ __forceinline__ int v_rd_base(int lane) { return ((lane & 3) << 3) | (((lane >> 2) & 3) << 6) | (((lane >> 4) & 1) << 5) | (((lane >> 5) & 1) << 8); }
constexpr int v_rd_off(int d0, int ks, int half) { return d0 * 512 + ks * 4096 + half * 2048; }

__device__ __forceinline__ void mask_tile(f32x16& p0, f32x16& p1, int dq) {
    const float NEG = -__builtin_inff();
#pragma unroll
    for (int r = 0; r < 16; ++r) {
        const int c = (r & 3) + 8 * (r >> 2);
        if (dq - c < 0) p0[r] = NEG;
        if (dq - c - 32 < 0) p1[r] = NEG;
    }
}
__device__ __forceinline__ void partialSM(f32x16& p0, f32x16& p1, float& m_reg, float& alpha) {
    float pmax = p0[0];
#pragma unroll
    for (int r = 1; r < 16; ++r) pmax = fmaxf(pmax, p0[r]);
#pragma unroll
    for (int r = 0; r < 16; ++r) pmax = fmaxf(pmax, p1[r]);
    { auto rr = __builtin_amdgcn_permlane32_swap(__float_as_uint(pmax), __float_as_uint(pmax), false, false);
      pmax = fmaxf(__uint_as_float(rr[0]), __uint_as_float(rr[1])); }
    float mn;
    if (__builtin_expect(__all((pmax - m_reg) <= THR2), 1)) { mn = m_reg; alpha = 1.f; }
    else { mn = fmaxf(m_reg, pmax); alpha = __builtin_amdgcn_exp2f(m_reg - mn); m_reg = mn; }
#pragma unroll
    for (int r = 0; r < 16; ++r) p0[r] = __builtin_amdgcn_exp2f(p0[r] - mn);
#pragma unroll
    for (int r = 0; r < 16; ++r) p1[r] = __builtin_amdgcn_exp2f(p1[r] - mn);
}
__device__ __forceinline__ void finishSM(const f32x16& p0, const f32x16& p1, float alpha, float& l_reg, b16x8& pa0, b16x8& pa1, b16x8& pa2, b16x8& pa3) {
    float ps = 0.f;
#pragma unroll
    for (int r = 0; r < 16; ++r) ps += p0[r];
#pragma unroll
    for (int r = 0; r < 16; ++r) ps += p1[r];
    { auto rr = __builtin_amdgcn_permlane32_swap(__float_as_uint(ps), __float_as_uint(ps), false, false);
      ps = __uint_as_float(rr[0]) + __uint_as_float(rr[1]); }
    l_reg = l_reg * alpha + ps;
#define ATT_PK4(P, B_, OUT) do { unsigned a0 = cvtpk(P[B_+0], P[B_+1]), a1 = cvtpk(P[B_+2], P[B_+3]);                          \
        unsigned b0 = cvtpk(P[B_+4], P[B_+5]), b1 = cvtpk(P[B_+6], P[B_+7]);                                             \
        auto r0 = __builtin_amdgcn_permlane32_swap(a0, b0, false, false); auto r1 = __builtin_amdgcn_permlane32_swap(a1, b1, false, false); \
        u32x4v w = {r0[0], r1[0], r0[1], r1[1]}; OUT = __builtin_bit_cast(b16x8, w); } while (0)
    ATT_PK4(p0, 0, pa0); ATT_PK4(p0, 8, pa1); ATT_PK4(p1, 0, pa2); ATT_PK4(p1, 8, pa3);
#undef ATT_PK4
}
template <int KB>
__device__ __forceinline__ void qkt(f32x16& p0, f32x16& p1, const LAS unsigned char* const (&kb4)[4], const b16x8 (&qr)[12]) {
    p0 = f32x16{}; p1 = f32x16{};
#pragma unroll
    for (int d0 = 0; d0 < 12; ++d0) {
        const LAS unsigned char* a = kb4[d0 & 3] + KB * KT + (d0 >> 2) * 128;
        const b16x8 b0 = *(const LAS b16x8*)a;
        const b16x8 b1 = *(const LAS b16x8*)(a + 32 * 384);
        p0 = __builtin_amdgcn_mfma_f32_32x32x16_bf16(b0, qr[d0], p0, 0, 0, 0);
        p1 = __builtin_amdgcn_mfma_f32_32x32x16_bf16(b1, qr[d0], p1, 0, 0, 0);
    }
}
template <int VB>
__device__ __forceinline__ void pv_tile(f32x16 (&o)[4], int vb0, b16x8 pa0, b16x8 pa1, b16x8 pa2, b16x8 pa3) {
#define ATT_TRRD(dst, off) asm volatile("ds_read_b64_tr_b16 %0, %1 offset:%2" : "=&v"(dst) : "v"(vb0), "i"(off) : "memory")
#define ATT_PV_D0(d0) do { s16x4 l0, l1, l2, l3, h0, h1, h2, h3; constexpr int b_ = LDS_V + VB * VT + v_rd_off(d0, 0, 0); \
        ATT_TRRD(l0, b_); ATT_TRRD(h0, b_ + 2048); ATT_TRRD(l1, b_ + 4096); ATT_TRRD(h1, b_ + 6144); ATT_TRRD(l2, b_ + 8192); ATT_TRRD(h2, b_ + 10240); ATT_TRRD(l3, b_ + 12288); ATT_TRRD(h3, b_ + 14336); \
        asm volatile("s_waitcnt lgkmcnt(0)" ::: "memory"); ATT_SBAR();   \
        o[d0] = __builtin_amdgcn_mfma_f32_32x32x16_bf16(pa0, (b16x8){l0[0], l0[1], l0[2], l0[3], h0[0], h0[1], h0[2], h0[3]}, o[d0], 0, 0, 0);   \
        o[d0] = __builtin_amdgcn_mfma_f32_32x32x16_bf16(pa1, (b16x8){l1[0], l1[1], l1[2], l1[3], h1[0], h1[1], h1[2], h1[3]}, o[d0], 0, 0, 0);   \
        o[d0] = __builtin_amdgcn_mfma_f32_32x32x16_bf16(pa2, (b16x8){l2[0], l2[1], l2[2], l2[3], h2[0], h2[1], h2[2], h2[3]}, o[d0], 0, 0, 0);   \
        o[d0] = __builtin_amdgcn_mfma_f32_32x32x16_bf16(pa3, (b16x8){l3[0], l3[1], l3[2], l3[3], h3[0], h3[1], h3[2], h3[3]}, o[d0], 0, 0, 0); } while (0)
    ATT_PV_D0(0); ATT_PV_D0(1); ATT_PV_D0(2); ATT_PV_D0(3);
#undef ATT_PV_D0
#undef ATT_TRRD
}

__device__ __forceinline__ void attn_block(const bf16* Qg, const bf16* Kg, const bf16* Vg, bf16* Og, int h, int qb, LAS unsigned char* lds, int wave, int lane) {
    const int r32 = lane & 31, hi = lane >> 5;
    const int P0 = qb * 256, NT = 4 * (qb + 1);
    const int qlo = P0 + wave * 32, qm = qlo + r32 - 4 * hi;
    unsigned koff[3], voff[2];
#pragma unroll
    for (int i = 0; i < 3; ++i) { const int o = (wave + 8 * i) * 1024 + lane * 16, key = o / 384, cc = (o - key * 384) >> 4, c = cc ^ ksw(key); koff[i] = (unsigned)(key * (8 * 384) + c * 16); }
#pragma unroll
    for (int i = 0; i < 2; ++i) { const int o = (wave + 8 * i) * 1024 + lane * 16, sub = o >> 9, kkhi = sub >> 2, cblk = sub & 3, rem = (o & 511) >> 1, kklo = rem >> 5, cl = rem & 31;
        const int kk = kkhi * 8 + kklo, k = (kk & ~0xC) | ((kk & 4) << 1) | ((kk & 8) >> 1), c = cblk * 32 + cl; voff[i] = (unsigned)(k * (8 * 256) + c * 2); }
    const char* kt = (const char*)(Kg + (size_t)h * 192);
    const char* vt = (const char*)(Vg + (size_t)h * 128);
#define ATT_ISSUE(BUF) do { \
        _Pragma("unroll") for (int _i = 0; _i < 3; ++_i) __builtin_amdgcn_global_load_lds((const unsigned*)(kt + koff[_i]), (LAS unsigned*)(lds + LDS_K + (BUF) * KT + (wave + 8 * _i) * 1024), 16, 0, 0); \
        _Pragma("unroll") for (int _i = 0; _i < 2; ++_i) __builtin_amdgcn_global_load_lds((const unsigned*)(vt + voff[_i]), (LAS unsigned*)(lds + LDS_V + (BUF) * VT + (wave + 8 * _i) * 1024), 16, 0, 0); \
        kt += 64 * 8 * 384; vt += 64 * 8 * 256; } while (0)
    b16x8 qr[12];
    { const bf16* qrow = Qg + ((size_t)(qlo + r32) * 8 + h) * 192 + hi * 8;
#pragma unroll
      for (int d0 = 0; d0 < 12; ++d0) qr[d0] = *(const GAS b16x8*)(qrow + d0 * 16); }
    ATT_ISSUE(0);
    const int ks_ = ksw(r32);
    const LAS unsigned char* const kb4[4] = { lds + LDS_K + r32 * 384 + (((0 + hi) ^ ks_) << 4), lds + LDS_K + r32 * 384 + (((2 + hi) ^ ks_) << 4),
                                              lds + LDS_K + r32 * 384 + (((4 + hi) ^ ks_) << 4), lds + LDS_K + r32 * 384 + (((6 + hi) ^ ks_) << 4) };
    const int vb0 = (int)((unsigned)(size_t)lds) + v_rd_base(lane);
    LAS float* al_l = (LAS float*)(lds + LDS_WS) + wave * 64; LAS float* li_l = al_l + 32;
    float m_reg = -1e30f, l_reg = 0.f; f32x16 o[4] = {};
#define ATT_RESC(a) do { if (__any((a) < 1.f)) { if (hi == 0) al_l[r32] = (a); asm volatile("s_waitcnt lgkmcnt(0)" ::: "memory");              \
                     _Pragma("unroll") for (int d_ = 0; d_ < 4; ++d_) _Pragma("unroll") for (int r = 0; r < 16; ++r) o[d_][r] *= al_l[crow(r, hi)]; } } while (0)
#define ATT_COMPUTE(BUF, t) do { f32x16 p0, p1; float alpha; b16x8 pa0, pa1, pa2, pa3; const int kb_ = (t) * 64; \
        qkt<BUF>(p0, p1, kb4, qr); \
        if (kb_ + 63 > qlo) mask_tile(p0, p1, qm - kb_); \
        partialSM(p0, p1, m_reg, alpha); finishSM(p0, p1, alpha, l_reg, pa0, pa1, pa2, pa3); ATT_RESC(alpha); \
        pv_tile<BUF>(o, vb0, pa0, pa1, pa2, pa3); } while (0)
    for (int t = 0; t < NT; t += 2) {
        ATT_ISSUE(1);
        asm volatile("s_waitcnt vmcnt(5)" ::: "memory"); __builtin_amdgcn_s_barrier(); asm volatile("" ::: "memory");
        ATT_COMPUTE(0, t);
        asm volatile("s_waitcnt lgkmcnt(0)" ::: "memory"); __builtin_amdgcn_s_barrier(); asm volatile("" ::: "memory");
        if (t + 2 < NT) { ATT_ISSUE(0); asm volatile("s_waitcnt vmcnt(5)" ::: "memory"); }
        else { asm volatile("s_waitcnt vmcnt(0)" ::: "memory"); }
        __builtin_amdgcn_s_barrier(); asm volatile("" ::: "memory");
        ATT_COMPUTE(1, t + 1);
        asm volatile("s_waitcnt lgkmcnt(0)" ::: "memory"); __builtin_amdgcn_s_barrier(); asm volatile("" ::: "memory");
    }
    if (hi == 0) li_l[r32] = l_reg;
    asm volatile("s_waitcnt lgkmcnt(0)" ::: "memory");
    float rli[16];
#pragma unroll
    for (int r = 0; r < 16; ++r) rli[r] = __builtin_amdgcn_rcpf(li_l[crow(r, hi)]);
    bf16* Ow = Og + (size_t)qlo * 2048 + h * 128;
#pragma unroll
    for (int r = 0; r < 16; ++r) { const int orow = crow(r, hi);
#pragma unroll
        for (int d0 = 0; d0 < 4; ++d0) { const float v = o[d0][r] * rli[r]; const float vn = __shfl_xor(v, 1);
            if ((r32 & 1) == 0) *(GAS unsigned*)(Ow + (size_t)orow * 2048 + d0 * 32 + r32) = cvtpk(v, vn); } }
#undef ATT_ISSUE
#undef ATT_RESC
#undef ATT_COMPUTE
}
}
__device__ __forceinline__ float bflo(unsigned w) { return __builtin_bit_cast(float, w << 16); }
__device__ __forceinline__ float bfhi(unsigned w) { return __builtin_bit_cast(float, w & 0xffff0000u); }
__device__ __forceinline__ float bf2f(bf16 b) { return __builtin_bit_cast(float, ((unsigned)b) << 16); }
__device__ __forceinline__ float wave_sum(float v) {
#pragma unroll
    for (int o = 1; o < 64; o <<= 1) v += __shfl_xor(v, o);
    return v;
}
__device__ __forceinline__ float wave_max(float v) {
#pragma unroll
    for (int o = 1; o < 64; o <<= 1) v = fmaxf(v, __shfl_xor(v, o));
    return v;
}
__device__ __forceinline__ float sigmoidf_(float x) { return 1.0f / (1.0f + __expf(-x)); }
__device__ __forceinline__ float siluf_(float x) { return x / (1.0f + __expf(-x)); }

struct MapId { __device__ __forceinline__ int operator()(int n) const { return n; } };
struct MapIn { __device__ __forceinline__ int operator()(int n) const { if (n < KR0 || n >= KR0 + 64) return n; const int i = n - KR0; return KR0 + (i < 32 ? 2 * i : 2 * (i - 32) + 1); } };
struct MapUq { __device__ __forceinline__ int operator()(int n) const { const int h = n / DQK, d = n - h * DQK; if (d < 128) return n; const int i = d - 128; return h * DQK + 128 + (i < 32 ? 2 * i : 2 * (i - 32) + 1); } };
struct MapGu { __device__ __forceinline__ int operator()(int n) const { const int isu = n >= FF ? 1 : 0, j = n - isu * FF; return 32 * (j >> 4) + 16 * isu + (j & 15); } };

template <class Map>
__device__ __forceinline__ void cvt_item(const float* W, int K, int N, bf16* WT, Map map, LAS float* scr, int item, int lane) {
    const int nblk = N / 32, kb = item / nblk, nb = item - kb * nblk, k0 = 64 * kb, n0 = 32 * nb;
    const int kr = lane >> 3, c4 = lane & 7;
#pragma unroll
    for (int i = 0; i < 8; ++i) {
        const f32x4 v = *(const GAS f32x4*)(W + (size_t)(k0 + 8 * i + kr) * N + n0 + 4 * c4);
        LAS float* s = scr + (8 * i + kr) * 33 + 4 * c4;
        s[0] = v.x; s[1] = v.y; s[2] = v.z; s[3] = v.w;
    }
    LDS_WAIT(); asm volatile("" ::: "memory");
#pragma unroll
    for (int j = 0; j < 4; ++j) {
        const int n = (lane >> 3) + 8 * j;
        const LAS float* s = scr + (8 * c4) * 33 + n;
        v4u o; o.x = pk2(s[0], s[33]); o.y = pk2(s[66], s[99]); o.z = pk2(s[132], s[165]); o.w = pk2(s[198], s[231]);
        *(GAS v4u*)(WT + (size_t)map(n0 + n) * K + k0 + 8 * c4) = o;
    }
    LDS_WAIT(); asm volatile("" ::: "memory");
}
template <class Map>
__device__ __forceinline__ void cvt_matrix(const float* W, int K, int N, bf16* WT, Map map, int& cum, int gw, int NGW, LAS float* scr, int lane) {
    const int nitems = (K / 64) * (N / 32);
    const int first = (gw - (cum % NGW) + NGW) % NGW;
    for (int it = first; it < nitems; it += NGW) cvt_item(W, K, N, WT, map, scr, it, lane);
    cum += nitems;
}

__device__ __forceinline__ void row_load(const float* row, int lane, f32x4 (&v)[8]) {
#pragma unroll
    for (int j = 0; j < 8; ++j) v[j] = ((const GAS f32x4*)row)[lane + 64 * j];
}
__device__ __forceinline__ void row_store(float* row, int lane, const f32x4 (&v)[8]) {
#pragma unroll
    for (int j = 0; j < 8; ++j) ((GAS f32x4*)row)[lane + 64 * j] = v[j];
}
__device__ __forceinline__ float row_ss(const f32x4 (&v)[8]) {
    float s = 0.f;
#pragma unroll
    for (int j = 0; j < 8; ++j) s += (v[j].x * v[j].x + v[j].y * v[j].y) + (v[j].z * v[j].z + v[j].w * v[j].w);
    return wave_sum(s);
}
__device__ __forceinline__ void row_store_bf16(bf16* row, int lane, const f32x4 (&v)[8]) {
    typedef unsigned u32x2v __attribute__((ext_vector_type(2)));
#pragma unroll
    for (int j = 0; j < 8; ++j) { u32x2v w; w.x = pk2(v[j].x, v[j].y); w.y = pk2(v[j].z, v[j].w); ((GAS u32x2v*)row)[lane + 64 * j] = w; }
}


namespace hg {
typedef float f32x16 __attribute__((ext_vector_type(16)));
typedef short b16x8 __attribute__((ext_vector_type(8)));
constexpr int QM_OFF = 0, KM_OFF = 17408, KET_OFF = 34816, VT_OFF = 53248, AL_OFF = 71680, TOT_OFF = 80896, LDS_TOTAL = 82944;
constexpr int QS = 272, TS = 144;
constexpr float L2E = 1.4426950408889634f;
__device__ __forceinline__ int crow(int r, int hi) { return (r & 3) + 8 * (r >> 2) + 4 * hi; }
__device__ __forceinline__ unsigned short f2b(float f) { unsigned u = __builtin_bit_cast(unsigned, f); return (unsigned short)((u + 0x7fffu + ((u >> 16) & 1u)) >> 16); }
__device__ __forceinline__ b16x8 ldfrag(const LAS unsigned char* p) { return *(const LAS b16x8*)p; }

__device__ __forceinline__ void h1_unit(int unit, const bf16* Zp, const float* lbp, bf16* Q0, float* OI, float* DST, float* Dd, LAS unsigned char* lds, int wave, int lane) {
    const int tid = wave * 64 + lane;
    const int c = unit & 63, bh = unit >> 6, h = bh & 7, b = bh >> 3;
    const size_t tok0 = (size_t)b * SEQ + (size_t)c * 64;
    const int k = tid & 127, seg = tid >> 7;
    LAS float* tot = (LAS float*)(lds + TOT_OFF);
#pragma unroll
    for (int j = 0; j < 2; ++j) { const int cid = tid + 512 * j, s = cid >> 4, v8 = (cid & 15) * 8;
        const v4u w = *(const GAS v4u*)(Zp + (tok0 + s) * ZW + HI0 + h * 128 + v8);
        LAS unsigned short* dst = (LAS unsigned short*)(lds + VT_OFF + v8 * TS + s * 2);
        dst[0 * (TS / 2)] = (unsigned short)(w.x & 0xffffu); dst[1 * (TS / 2)] = (unsigned short)(w.x >> 16); dst[2 * (TS / 2)] = (unsigned short)(w.y & 0xffffu); dst[3 * (TS / 2)] = (unsigned short)(w.y >> 16);
        dst[4 * (TS / 2)] = (unsigned short)(w.z & 0xffffu); dst[5 * (TS / 2)] = (unsigned short)(w.z >> 16); dst[6 * (TS / 2)] = (unsigned short)(w.w & 0xffffu); dst[7 * (TS / 2)] = (unsigned short)(w.w >> 16); }
    const float lbv = lbp[h * 128 + k], lbc = fmaxf(lbv, 1e-30f), oml = 1.0f - lbv;
    const bf16* zq = Zp + (tok0 + 16 * seg) * ZW + HQ0 + h * 128 + k;
    float q[16], kk[16], bl[16]; float run = 0.f;
#pragma unroll
    for (int i = 0; i < 16; ++i) {
        const float qr = bf2f(zq[(size_t)i * ZW]); float fr = bf2f(zq[(size_t)i * ZW + (HF0 - HQ0)]);
        fr = fminf(fmaxf(fr, -80.f), 80.f);
        const float e = __builtin_amdgcn_exp2f(-fr * L2E), sg = __builtin_amdgcn_rcpf(1.0f + e);
        const float f = lbc + oml * sg;
        kk[i] = oml * (e * sg);
        q[i] = qr * __builtin_amdgcn_rcpf(1.0f + __builtin_amdgcn_exp2f(-qr * L2E));
        run += __builtin_amdgcn_logf(f); bl[i] = run;
    }
    tot[seg * 128 + k] = run;
    __syncthreads();
    const float t0 = tot[k], t1 = tot[128 + k], t2 = tot[256 + k], t3 = tot[384 + k];
    const float off = seg == 0 ? 0.f : seg == 1 ? t0 : seg == 2 ? t0 + t1 : (t0 + t1) + t2;
    const float bmid = t0 + t1, blast = (t0 + t1) + (t2 + t3);
    unsigned kev[8];
#pragma unroll
    for (int i = 0; i < 16; ++i) {
        const float bb = bl[i] + off; const int t = 16 * seg + i;
        const float qm = q[i] * __builtin_amdgcn_exp2f(bb - bmid), km = kk[i] * __builtin_amdgcn_exp2f(bmid - bb), q0 = q[i] * __builtin_amdgcn_exp2f(bb), ke = kk[i] * __builtin_amdgcn_exp2f(blast - bb);
        *(LAS unsigned short*)(lds + QM_OFF + t * QS + k * 2) = f2b(qm);
        *(LAS unsigned short*)(lds + KM_OFF + t * QS + k * 2) = f2b(km);
        Q0[(tok0 + t) * 1024 + h * 128 + k] = f2b(q0);
        if (i & 1) kev[i >> 1] |= ((unsigned)f2b(ke)) << 16; else kev[i >> 1] = (unsigned)f2b(ke);
    }
    { LAS v4u* d = (LAS v4u*)(lds + KET_OFF + k * TS + 32 * seg); d[0] = (v4u){kev[0], kev[1], kev[2], kev[3]}; d[1] = (v4u){kev[4], kev[5], kev[6], kev[7]}; }
    if (seg == 3) Dd[(size_t)unit * 128 + k] = __builtin_amdgcn_exp2f(blast);
    __syncthreads();
    const int r32 = lane & 31, hi = lane >> 5;
    if (wave < 4) {
        const int ti = wave == 0 ? 0 : 1, si = wave <= 1 ? 0 : 1;
        f32x16 acc = {};
        if (wave < 3) {
            const LAS unsigned char* ap = lds + QM_OFF + (32 * ti + r32) * QS + hi * 16; const LAS unsigned char* bp = lds + KM_OFF + (32 * si + r32) * QS + hi * 16;
#pragma unroll
            for (int ks = 0; ks < 8; ++ks) acc = __builtin_amdgcn_mfma_f32_32x32x16_bf16(ldfrag(ap + ks * 32), ldfrag(bp + ks * 32), acc, 0, 0, 0);
        }
        const int tiw = wave == 3 ? 0 : ti, siw = wave == 3 ? 1 : si;
#pragma unroll
        for (int r = 0; r < 16; ++r) { const int t = 32 * tiw + crow(r, hi), s = 32 * siw + r32; const float a = (wave < 3 && s <= t) ? acc[r] : 0.f;
            *(LAS unsigned short*)(lds + AL_OFF + t * TS + s * 2) = f2b(a); }
    }
    {
        const int vi = wave >> 1;
#pragma unroll
        for (int jj = 0; jj < 2; ++jj) { const int kj = 2 * (wave & 1) + jj; f32x16 acc = {};
            const LAS unsigned char* ap = lds + VT_OFF + (32 * vi + r32) * TS + hi * 16; const LAS unsigned char* bp = lds + KET_OFF + (32 * kj + r32) * TS + hi * 16;
#pragma unroll
            for (int ks = 0; ks < 4; ++ks) acc = __builtin_amdgcn_mfma_f32_32x32x16_bf16(ldfrag(ap + ks * 32), ldfrag(bp + ks * 32), acc, 0, 0, 0);
            float* dst = DST + ((size_t)unit * 128 + 32 * vi) * 128 + 32 * kj + r32;
#pragma unroll
            for (int r = 0; r < 16; ++r) dst[(size_t)crow(r, hi) * 128] = acc[r]; }
    }
    __syncthreads();
    {
        const int ti = wave >> 2, vi = wave & 3; f32x16 acc = {};
        const LAS unsigned char* ap = lds + AL_OFF + (32 * ti + r32) * TS + hi * 16; const LAS unsigned char* bp = lds + VT_OFF + (32 * vi + r32) * TS + hi * 16;
#pragma unroll
        for (int ks = 0; ks < 4; ++ks) acc = __builtin_amdgcn_mfma_f32_32x32x16_bf16(ldfrag(ap + ks * 32), ldfrag(bp + ks * 32), acc, 0, 0, 0);
        float* dst = OI + (tok0 + 32 * ti) * 1024 + h * 128 + 32 * vi + r32;
#pragma unroll
        for (int r = 0; r < 16; ++r) dst[(size_t)crow(r, hi) * 1024] = acc[r];
    }
    __syncthreads();
}

__device__ __forceinline__ void h2_scan(const float* DST, const float* Dd, bf16* ST, int gtid, int gthreads) {
    typedef unsigned u32x2v __attribute__((ext_vector_type(2)));
    for (int e = gtid; e < 32 * 4096; e += gthreads) {
        const int bh = e >> 12, v = (e >> 5) & 127, k4 = e & 31;
        f32x4 S = {0.f, 0.f, 0.f, 0.f};
#pragma unroll 4
        for (int c = 0; c < 64; ++c) { const size_t unit = (size_t)bh * 64 + c;
            const f32x4 ds = *(const GAS f32x4*)(DST + (unit * 128 + v) * 128 + 4 * k4), dd = *(const GAS f32x4*)(Dd + unit * 128 + 4 * k4);
            u32x2v w; w.x = pk2(S.x, S.y); w.y = pk2(S.z, S.w);
            *(GAS u32x2v*)(ST + (unit * 128 + v) * 128 + 4 * k4) = w;
            S = dd * S + ds; }
    }
}

__device__ __forceinline__ void h3_unit(int unit, const bf16* Zp, const bf16* Q0, const float* OI, const bf16* ST, const float* on, bf16* Yp, LAS unsigned char* lds, int wave, int lane) {
    const int c = unit & 63, bh = unit >> 6, h = bh & 7, b = bh >> 3;
    const size_t tok0 = (size_t)b * SEQ + (size_t)c * 64;
    const int r32 = lane & 31, hi = lane >> 5, ti = wave >> 2, vi = wave & 3;
    LAS float* os = (LAS float*)lds;
    f32x16 acc = {};
    const bf16* qa = Q0 + (tok0 + 32 * ti + r32) * 1024 + h * 128 + 8 * hi;
    const bf16* sb = ST + ((size_t)unit * 128 + 32 * vi + r32) * 128 + 8 * hi;
#pragma unroll
    for (int ks = 0; ks < 8; ++ks) acc = __builtin_amdgcn_mfma_f32_32x32x16_bf16(*(const GAS b16x8*)(qa + 16 * ks), *(const GAS b16x8*)(sb + 16 * ks), acc, 0, 0, 0);
    const float* oi = OI + (tok0 + 32 * ti) * 1024 + h * 128 + 32 * vi + r32;
#pragma unroll
    for (int r = 0; r < 16; ++r) { const int t = crow(r, hi); os[(32 * ti + t) * 128 + 32 * vi + r32] = acc[r] + oi[(size_t)t * 1024]; }
    __syncthreads();
#pragma unroll
    for (int j = 0; j < 8; ++j) { const int t = wave * 8 + j;
        const float x0 = os[t * 128 + lane], x1 = os[t * 128 + 64 + lane];
        const float rstd = rsqrtf(wave_sum(x0 * x0 + x1 * x1) * (1.0f / 128.0f) + EPS);
        const bf16* zg = Zp + (tok0 + t) * ZW + HG0 + h * 128;
        const float g0 = bf2f(zg[lane]), g1 = bf2f(zg[64 + lane]);
        bf16* yr = Yp + (tok0 + t) * DM + 1024 + h * 128;
        yr[lane] = f2b(x0 * rstd * on[lane] * (g0 * __builtin_amdgcn_rcpf(1.0f + __builtin_amdgcn_exp2f(-g0 * L2E))));
        yr[64 + lane] = f2b(x1 * rstd * on[64 + lane] * (g1 * __builtin_amdgcn_rcpf(1.0f + __builtin_amdgcn_exp2f(-g1 * L2E)))); }
    __syncthreads();
}
}
struct Args { const float* in[20]; float* out; unsigned char* ws; int ph_lo, ph_hi; };

constexpr int NPL = 33;
constexpr int NPH = 1 + DEPTH * NPL;

#define CAS __attribute__((address_space(4)))
typedef const float* cfp_t;
#define KARG_IN(k) (*(const cfp_t CAS*)(ka + 8 * (k)))
__device__ __forceinline__ int launder_v(int v) { asm volatile("" : "+v"(v)); return v; }
__device__ __forceinline__ const CAS unsigned char* launder_ka() { const CAS unsigned char* p = (const CAS unsigned char*)__builtin_amdgcn_kernarg_segment_ptr(); asm volatile("" : "+s"(p)); return p; }
#define PHASE_BEGIN const int lane = hw_lane(), tid = wave * 64 + lane; const CAS unsigned char* ka = launder_ka(); unsigned char* const wsl = *(unsigned char* const CAS*)(ka + 168); \
    const int gw = bid * NWAVES + wave, NGW = G * NWAVES; (void)tid; (void)lane; (void)ka; (void)wsl; (void)gw; (void)NGW;
#define I_x          (KARG_IN(0))
#define I_pin        (KARG_IN(1))
#define I_positions  ((const int*)KARG_IN(2))
#define I_snorm      (KARG_IN(3))
#define I_w_in       (KARG_IN(4))
#define I_qnorm      (KARG_IN(5))
#define I_kvnorm     (KARG_IN(6))
#define I_w_uq       (KARG_IN(7))
#define I_w_ukv      (KARG_IN(8))
#define I_lbl        (KARG_IN(9))
#define I_onorm      (KARG_IN(10))
#define I_w_out      (KARG_IN(11))
#define I_f_gu       (KARG_IN(12))
#define I_f_dn       (KARG_IN(13))
#define I_m_rt       (KARG_IN(14))
#define I_m_gu       (KARG_IN(15))
#define I_m_dn       (KARG_IN(16))
#define I_p_wp       (KARG_IN(17))
#define I_p_wg       (KARG_IN(18))
#define I_p_nm       (KARG_IN(19))
#define I_out        (*(float* const CAS*)(ka + 160))
#define W_LB   ((float*)(wsl + WS_LB))
#define W_COS  ((float*)(wsl + WS_COS))
#define W_SIN  ((float*)(wsl + WS_SIN))
#define W_SELE ((int*)(wsl + WS_SELE))
#define W_SELG ((float*)(wsl + WS_SELG))
#define W_WIN  ((bf16*)(wsl + WS_WIN))
#define W_WUQ  ((bf16*)(wsl + WS_WUQ))
#define W_WUKV ((bf16*)(wsl + WS_WUKV))
#define W_WOUT ((bf16*)(wsl + WS_WOUT))
#define W_WGU  ((bf16*)(wsl + WS_WGU))
#define W_WDN  ((bf16*)(wsl + WS_WDN))
#define W_MGU  ((bf16*)(wsl + WS_MGU))
#define W_MDN  ((bf16*)(wsl + WS_MDN))
#define W_WPP  ((bf16*)(wsl + WS_WPP))
#define W_WPG  ((bf16*)(wsl + WS_WPG))
#define W_XN   ((bf16*)(wsl + WS_XN))
#define W_Z    ((bf16*)(wsl + WS_Z))
#define W_CQ   ((bf16*)(wsl + WS_CQ))
#define W_CKV  ((bf16*)(wsl + WS_CKV))
#define W_KPE  ((bf16*)(wsl + WS_KPE))
#define W_Q    ((bf16*)(wsl + WS_Q))
#define W_K192 ((bf16*)(wsl + WS_K192))
#define W_V    ((bf16*)(wsl + WS_V))
#define W_Y    ((bf16*)(wsl + WS_Y))
#define W_YO   ((float*)(wsl + WS_YO))
#define W_PP   ((float*)(wsl + WS_PP))
#define W_PB   ((bf16*)(wsl + WS_PB))
#define W_POS  ((int*)(wsl + WS_POS))
#define W_TBL  ((int*)(wsl + WS_TBL))
#define W_XP   ((bf16*)(wsl + WS_XP))
#define W_YP   ((float*)(wsl + WS_YP))
#define W_HB   ((bf16*)(wsl + WS_HB))
#define W_HQ0  ((bf16*)(wsl + WS_HB))
#define W_HOI  ((float*)(wsl + WS_HB + 32 * MiB))
#define W_HDS  ((float*)(wsl + WS_HB + 96 * MiB))
#define W_HD   ((float*)(wsl + WS_HB + 224 * MiB))
#define W_HST  ((bf16*)(wsl + WS_HB + 225 * MiB))

#define PH(k) (lo <= (k) && (k) < hi)
#define SEAM(k) do { if (lo <= (k) && (k) + 1 < hi) xcd_barrier(bar); } while (0)

template <int l>
__device__ __forceinline__ void layer_phases(const int lo, const int hi, const XcdBarrier& bar, LAS unsigned char* lds, const int wave, const int G, const int bid) {
        const int base = 1 + l * NPL;
#define SN_L (I_snorm + (size_t)l * 4 * DM)
        if (PH(base + 0)) { PHASE_BEGIN
            pg8::Gemm g{W_XN, W_WIN + (size_t)l * ZW * DM, T, ZW, DM}; pg8::StaticOrder S; S.init(T, ZW, G, bid);
            pg8::EpiBf16P E{W_Z, ZW};
            pg8::gemm_phase<pg8::EpiBf16P, pg8::StaticOrder, true, true>(lds, g, S, E, wave);
        }
        SEAM(base + 0);
        if (PH(base + 1)) { PHASE_BEGIN
            const float* qn = I_qnorm + (size_t)l * QRANK; const float* kn = I_kvnorm + (size_t)l * KVRANK;
            for (int m = gw; m < T; m += NGW) {
                const bf16* zr = W_Z + (size_t)m * ZW;
                unsigned a[3]; float ss = 0.f;
#pragma unroll
                for (int j = 0; j < 3; ++j) { a[j] = *(const GAS unsigned*)(zr + CQ0 + 2 * lane + 128 * j); const float lo_ = bflo(a[j]), hi_ = bfhi(a[j]); ss += lo_ * lo_ + hi_ * hi_; }
                float rstd = rsqrtf(wave_sum(ss) * (1.0f / QRANK) + EPS);
#pragma unroll
                for (int j = 0; j < 3; ++j) { const int c = 2 * lane + 128 * j; *(GAS unsigned*)(W_CQ + (size_t)m * QRANK + c) = pk2(bflo(a[j]) * rstd * qn[c], bfhi(a[j]) * rstd * qn[c + 1]); }
                unsigned b2[2]; ss = 0.f;
#pragma unroll
                for (int j = 0; j < 2; ++j) { b2[j] = *(const GAS unsigned*)(zr + CKV0 + 2 * lane + 128 * j); const float lo_ = bflo(b2[j]), hi_ = bfhi(b2[j]); ss += lo_ * lo_ + hi_ * hi_; }
                rstd = rsqrtf(wave_sum(ss) * (1.0f / KVRANK) + EPS);
#pragma unroll
                for (int j = 0; j < 2; ++j) { const int c = 2 * lane + 128 * j; *(GAS unsigned*)(W_CKV + (size_t)m * KVRANK + c) = pk2(bflo(b2[j]) * rstd * kn[c], bfhi(b2[j]) * rstd * kn[c + 1]); }
                if (lane < 32) { const unsigned w = *(const GAS unsigned*)(zr + KR0 + 2 * lane); const float x1 = bflo(w), x2 = bfhi(w), c = W_COS[(size_t)m * 32 + lane], s = W_SIN[(size_t)m * 32 + lane];
                    const unsigned kp = pk2(x1 * c - x2 * s, x2 * c + x1 * s);
#pragma unroll
                    for (int hh_ = 0; hh_ < NH; ++hh_) *(GAS unsigned*)(W_K192 + ((size_t)m * NH + hh_) * DQK + 128 + 2 * lane) = kp; }
            }
            for (int unit = bid; unit < NBATCH * NH * (SEQ / 64); unit += G) hg::h1_unit(unit, W_Z, W_LB + (size_t)l * 1024, W_HQ0, W_HOI, W_HDS, W_HD, lds, wave, lane);
        }
        SEAM(base + 1);
        if (PH(base + 2)) { PHASE_BEGIN
            { pg8::Gemm g{W_CQ, W_WUQ + (size_t)l * QW * QRANK, T, QW, QRANK}; pg8::StaticOrder S; S.init(T, QW, G, bid);
              pg8::EpiQRope E{W_Q, QW, W_COS, W_SIN, QSCALE};
              pg8::gemm_phase<pg8::EpiQRope, pg8::StaticOrder, true, true>(lds, g, S, E, wave); }
            { pg8::Gemm g{W_CKV, W_WUKV + (size_t)l * KVW * KVRANK, T, KVW, KVRANK}; pg8::StaticOrder S; S.init(T, KVW, G, bid);
              pg8::EpiKV E{W_K192, W_V};
              pg8::gemm_phase<pg8::EpiKV, pg8::StaticOrder, true, true>(lds, g, S, E, wave); }
            { pg8::Gemm g{W_PB + (size_t)l * T * PLE, W_WPP + (size_t)l * DM * PLE, T, DM, PLE}; pg8::StaticOrder S; S.init(T, DM, G, bid);
              pg8::EpiF32P E{W_PP, DM};
              pg8::gemm_phase<pg8::EpiF32P, pg8::StaticOrder, true, true>(lds, g, S, E, wave); }
            hg::h2_scan(W_HDS, W_HD, W_HST, bid * 512 + tid, G * 512);
        }
        SEAM(base + 2);
        if (PH(base + 3)) { PHASE_BEGIN
            for (int unit = bid; unit < NBATCH * NH * (SEQ / 64); unit += G) hg::h3_unit(unit, W_Z, W_HQ0, W_HOI, W_HST, I_onorm + (size_t)l * 128, W_Y, lds, wave, lane);
            {
                const int vcu = (G % 8 == 0) ? (bid % 8) * (G / 8) + bid / 8 : bid;
                for (int u = vcu; u < NBATCH * NH * 8; u += G) {
                    const int bh = u >> 3, xq = u & 7, b = bh >> 3, h = bh & 7;
                    for (int pass = 0; pass < 2; ++pass) {
                        const int qb = pass ? xq : 15 - xq;
                        att::attn_block(W_Q + (size_t)b * SEQ * QW, W_K192 + (size_t)b * SEQ * QW, W_V + (size_t)b * SEQ * 1024, W_Y + (size_t)b * SEQ * DM, h, qb, lds, wave, lane);
                    }
                }
            }
        }
        SEAM(base + 3);
        if (PH(base + 4)) { PHASE_BEGIN
            pg8::Gemm g{W_Y, W_WOUT + (size_t)l * DM * DM, T, DM, DM}; pg8::StaticOrder S; S.init(T, DM, G, bid);
            pg8::EpiF32P E{W_YO, DM};
            pg8::gemm_phase<pg8::EpiF32P, pg8::StaticOrder, true, true>(lds, g, S, E, wave);
        }
        SEAM(base + 4);
        if (PH(base + 5)) { PHASE_BEGIN
            const float* hin = (l == 0) ? I_x : I_out;
            const float* wr = I_m_rt + (size_t)(l / 2) * DM * NE;
            for (int m = gw; m < T; m += NGW) {
                f32x4 y[8], hh[8], g[8]; row_load(W_YO + (size_t)m * DM, lane, y); row_load(hin + (size_t)m * DM, lane, hh); row_load(SN_L + DM, lane, g);
                float rstd = rsqrtf(row_ss(y) * (1.0f / DM) + EPS);
#pragma unroll
                for (int j = 0; j < 8; ++j) hh[j] = hh[j] + y[j] * rstd * g[j];
                row_store(I_out + (size_t)m * DM, lane, hh);
                row_load(SN_L + 2 * DM, lane, g);
                rstd = rsqrtf(row_ss(hh) * (1.0f / DM) + EPS);
#pragma unroll
                for (int j = 0; j < 8; ++j) hh[j] = hh[j] * rstd * g[j];
                row_store_bf16(W_XN + (size_t)m * DM, lane, hh);
                if (l & 1) {
                    float lg[8];
#pragma unroll
                    for (int e = 0; e < 8; ++e) lg[e] = 0.f;
#pragma unroll
                    for (int j = 0; j < 8; ++j)
#pragma unroll
                        for (int i = 0; i < 4; ++i) { const int k = 256 * j + 4 * lane + i; const f32x4 w0 = *(const GAS f32x4*)(wr + (size_t)k * 8), w1 = *(const GAS f32x4*)(wr + (size_t)k * 8 + 4); const float c = hh[j][i];
                            lg[0] += c * w0.x; lg[1] += c * w0.y; lg[2] += c * w0.z; lg[3] += c * w0.w; lg[4] += c * w1.x; lg[5] += c * w1.y; lg[6] += c * w1.z; lg[7] += c * w1.w; }
#pragma unroll
                    for (int e = 0; e < 8; ++e) lg[e] = wave_sum(lg[e]);
                    int e0 = 0; float v0 = lg[0];
#pragma unroll
                    for (int e = 1; e < 8; ++e) if (lg[e] > v0) { v0 = lg[e]; e0 = e; }
                    int e1 = -1; float v1 = -__builtin_inff();
#pragma unroll
                    for (int e = 0; e < 8; ++e) if (e != e0 && lg[e] > v1) { v1 = lg[e]; e1 = e; }
                    const float ex = __expf(v1 - v0), g0 = 1.0f / (1.0f + ex), g1 = ex / (1.0f + ex);
                    if (lane == 0) { W_SELE[m] = e0 | (e1 << 8); W_SELG[2 * m] = g0; W_SELG[2 * m + 1] = g1; }
                }
            }
        }
        SEAM(base + 5);
        if ((l & 1) == 0) {
            if (PH(base + 6)) { PHASE_BEGIN
                pg8::Gemm g{W_XN, W_WGU, T, GU, DM}; pg8::StaticOrder S; S.init(T, GU, G, bid);
                pg8::EpiSwiGLU E{W_HB, FF, GU / 256};
                pg8::gemm_phase<pg8::EpiSwiGLU, pg8::StaticOrder, true, true>(lds, g, S, E, wave);
            }
            SEAM(base + 6);
            if (PH(base + 7)) { PHASE_BEGIN
                pg8::Gemm g{W_HB, W_WDN, T, DM, FF}; pg8::StaticOrder S; S.init(T, DM, G, bid);
                pg8::EpiF32P E{W_YO, DM};
                pg8::gemm_phase<pg8::EpiF32P, pg8::StaticOrder, true, true>(lds, g, S, E, wave);
            }
            SEAM(base + 7);
        } else {
            if (PH(base + 8)) { PHASE_BEGIN
                LAS unsigned* wtot = (LAS unsigned*)lds;
                LAS int* posl = (LAS int*)(lds + 1024);
                unsigned cnt[8];
#pragma unroll
                for (int k = 0; k < 8; ++k) cnt[k] = 0u;
                { const GAS v4u* se4 = (const GAS v4u*)(W_SELE + tid * 32);
#pragma unroll
                  for (int j = 0; j < 8; ++j) { const v4u s4 = se4[j];
#pragma unroll
                      for (int q = 0; q < 4; ++q) { const unsigned s = q == 0 ? s4.x : q == 1 ? s4.y : q == 2 ? s4.z : s4.w; const unsigned e0 = s & 255u, e1 = (s >> 8) & 255u;
#pragma unroll
                          for (int k = 0; k < 8; ++k) cnt[k] += (e0 == (unsigned)k ? 1u : 0u) + (e1 == (unsigned)k ? 1u : 0u); } } }
                unsigned inc[8];
#pragma unroll
                for (int k = 0; k < 8; ++k) { unsigned v = cnt[k];
#pragma unroll
                    for (int o = 1; o < 64; o <<= 1) { const unsigned t = __shfl_up(v, o); if (lane >= o) v += t; }
                    inc[k] = v; if (lane == 63) wtot[wave * 8 + k] = v; }
                __syncthreads();
                unsigned excl[8], rowbase[8]; int tbv[9]; tbv[0] = 0;
#pragma unroll
                for (int k = 0; k < 8; ++k) { unsigned before = 0u, total = 0u;
#pragma unroll
                    for (int w = 0; w < 8; ++w) { const unsigned t = wtot[w * 8 + k]; total += t; before += (w < wave) ? t : 0u; }
                    excl[k] = before + inc[k] - cnt[k]; rowbase[k] = (unsigned)tbv[k] * 256u; tbv[k + 1] = tbv[k] + (int)((total + 255u) >> 8); }
                if (bid == 0 && tid == 0) {
#pragma unroll
                    for (int k = 0; k < 9; ++k) W_TBL[k] = tbv[k]; }
                for (int blk = bid; blk < T / 64; blk += G) {
                    if ((tid >> 1) == blk) {
                        const int* se = W_SELE + tid * 32;
                        for (int j = 0; j < 32; ++j) { const unsigned s = (unsigned)se[j]; const unsigned e0 = s & 255u, e1 = (s >> 8) & 255u; unsigned p0 = 0u, p1 = 0u;
#pragma unroll
                            for (int k = 0; k < 8; ++k) { const unsigned here = rowbase[k] + excl[k]; p0 = (e0 == (unsigned)k) ? here : p0; p1 = (e1 == (unsigned)k) ? here : p1; excl[k] += (e0 == (unsigned)k ? 1u : 0u) + (e1 == (unsigned)k ? 1u : 0u); }
                            const int tok = tid * 32 + j; W_POS[2 * tok] = (int)p0; W_POS[2 * tok + 1] = (int)p1; posl[((tid & 1) * 32 + j) * 2] = (int)p0; posl[((tid & 1) * 32 + j) * 2 + 1] = (int)p1; }
                    }
                    __syncthreads();
                    for (int tt = wave; tt < 64; tt += 8) {
                        const int tok = blk * 64 + tt; const int p0 = posl[2 * tt], p1 = posl[2 * tt + 1];
                        const GAS v4u* src = (const GAS v4u*)(W_XN + (size_t)tok * DM); GAS v4u* d0 = (GAS v4u*)(W_XP + (size_t)p0 * DM); GAS v4u* d1 = (GAS v4u*)(W_XP + (size_t)p1 * DM);
#pragma unroll
                        for (int j = 0; j < 4; ++j) { const v4u v = src[lane + 64 * j]; d0[lane + 64 * j] = v; d1[lane + 64 * j] = v; }
                    }
                    __syncthreads();
                }
            }
            SEAM(base + 8);
            if (PH(base + 9)) { PHASE_BEGIN
                pg8::Gemm g{W_XP, W_MGU, MOE_ROWS, GU, DM}; pg8::MoeOrder S; S.init(W_TBL, GU / 256, G, bid);
                pg8::EpiSwiGLU E{W_HB, FF, GU / 256};
                pg8::gemm_phase<pg8::EpiSwiGLU, pg8::MoeOrder, true, true>(lds, g, S, E, wave);
            }
            SEAM(base + 9);
            if (PH(base + 10)) { PHASE_BEGIN
                pg8::Gemm g{W_HB, W_MDN, MOE_ROWS, DM, FF}; pg8::MoeOrder S; S.init(W_TBL, DM / 256, G, bid);
                pg8::EpiF32M E{W_YP, DM, DM / 256};
                pg8::gemm_phase<pg8::EpiF32M, pg8::MoeOrder, true, true>(lds, g, S, E, wave);
            }
            SEAM(base + 10);
        }
        if (PH(base + 30)) { PHASE_BEGIN
            for (int m = gw; m < T; m += NGW) {
                f32x4 y[8], hh[8], g[8];
                if (l & 1) { const int p0 = W_POS[2 * m], p1 = W_POS[2 * m + 1]; const float g0 = W_SELG[2 * m], g1 = W_SELG[2 * m + 1];
                    row_load(W_YP + (size_t)p0 * DM, lane, y); row_load(W_YP + (size_t)p1 * DM, lane, hh);
#pragma unroll
                    for (int j = 0; j < 8; ++j) y[j] = y[j] * g0 + hh[j] * g1; }
                else row_load(W_YO + (size_t)m * DM, lane, y); row_load(I_out + (size_t)m * DM, lane, hh); row_load(SN_L + 3 * DM, lane, g);
                const float rstd = rsqrtf(row_ss(y) * (1.0f / DM) + EPS);
#pragma unroll
                for (int j = 0; j < 8; ++j) hh[j] = hh[j] + y[j] * rstd * g[j];
                row_store(I_out + (size_t)m * DM, lane, hh);
                row_store_bf16(W_XN + (size_t)m * DM, lane, hh);
            }
        }
        SEAM(base + 30);
        if (PH(base + 31)) { PHASE_BEGIN
            pg8::Gemm g{W_XN, W_WPG + (size_t)l * DM * DM, T, DM, DM}; pg8::StaticOrder S; S.init(T, DM, G, bid);
            pg8::EpiPleGate E{W_YO, W_PP, DM};
            pg8::gemm_phase<pg8::EpiPleGate, pg8::StaticOrder, true, true>(lds, g, S, E, wave);
        }
        SEAM(base + 31);
        if (PH(base + 32)) { PHASE_BEGIN
            for (int m = gw; m < T; m += NGW) {
                f32x4 y[8], hh[8], g[8]; row_load(W_YO + (size_t)m * DM, lane, y); row_load(I_out + (size_t)m * DM, lane, hh); row_load(I_p_nm + (size_t)l * DM, lane, g);
                float rstd = rsqrtf(row_ss(y) * (1.0f / DM) + EPS);
#pragma unroll
                for (int j = 0; j < 8; ++j) hh[j] = hh[j] + y[j] * rstd * g[j];
                row_store(I_out + (size_t)m * DM, lane, hh);
                if (l + 1 < DEPTH) {
                    row_load(I_snorm + (size_t)(l + 1) * 4 * DM, lane, g);
                    rstd = rsqrtf(row_ss(hh) * (1.0f / DM) + EPS);
#pragma unroll
                    for (int j = 0; j < 8; ++j) hh[j] = hh[j] * rstd * g[j];
                    row_store_bf16(W_XN + (size_t)m * DM, lane, hh);
                }
            }
        }
        SEAM(base + 32);
    }

__global__ void __launch_bounds__(NWAVES * 64, 2) mk_fwd(Args args) {
    extern __shared__ __attribute__((aligned(16))) unsigned char lds_raw[];
    LAS unsigned char* lds = (LAS unsigned char*)lds_raw;
    volatile LAS unsigned* MISC = (volatile LAS unsigned*)(lds + MISC_OFF);
    const int wave = __builtin_amdgcn_readfirstlane((int)threadIdx.x >> 6);
    const int G = gridDim.x, bid = blockIdx.x;
    gu32* ctl = (gu32*)(args.ws + WS_CTL);
    for (int u = threadIdx.x; u < (LDS_BYTES - RING_BYTES) / 4; u += NWAVES * 64) ((LAS unsigned*)(lds + RING_BYTES))[u] = 0u;
    __syncthreads();
    const int lo = args.ph_lo, hi = args.ph_hi;
    const bool multi = (hi - lo) > 1;
    XcdBarrier bar; bar.bar = (unsigned*)(ctl + CW_BAR); bar.x = 0; bar.st = nullptr; bar.w = wave;
    if (multi) bar = xcd_barrier_post((unsigned*)(ctl + CW_BAR), MISC + 8);

    if (PH(0)) { PHASE_BEGIN
        LAS float* scr = (LAS float*)(lds + wave * 16384);
        int cum = 0;
        for (int l = 0; l < DEPTH; ++l) {
            cvt_matrix(I_w_in + (size_t)l * DM * ZREAL, DM, ZREAL, W_WIN + (size_t)l * ZW * DM, MapIn{}, cum, gw, NGW, scr, lane);
            cvt_matrix(I_w_uq + (size_t)l * QRANK * QW, QRANK, QW, W_WUQ + (size_t)l * QW * QRANK, MapUq{}, cum, gw, NGW, scr, lane);
            cvt_matrix(I_w_ukv + (size_t)l * KVRANK * KVW, KVRANK, KVW, W_WUKV + (size_t)l * KVW * KVRANK, MapId{}, cum, gw, NGW, scr, lane);
            cvt_matrix(I_w_out + (size_t)l * DM * DM, DM, DM, W_WOUT + (size_t)l * DM * DM, MapId{}, cum, gw, NGW, scr, lane);
            cvt_matrix(I_p_wp + (size_t)l * PLE * DM, PLE, DM, W_WPP + (size_t)l * DM * PLE, MapId{}, cum, gw, NGW, scr, lane);
            cvt_matrix(I_p_wg + (size_t)l * DM * DM, DM, DM, W_WPG + (size_t)l * DM * DM, MapId{}, cum, gw, NGW, scr, lane);
        }
        cvt_matrix(I_f_gu, DM, GU, W_WGU, MapGu{}, cum, gw, NGW, scr, lane);
        cvt_matrix(I_f_dn, FF, DM, W_WDN, MapId{}, cum, gw, NGW, scr, lane);
        for (int e = 0; e < NE; ++e) {
            cvt_matrix(I_m_gu + (size_t)e * DM * GU, DM, GU, W_MGU + (size_t)e * GU * DM, MapGu{}, cum, gw, NGW, scr, lane);
            cvt_matrix(I_m_dn + (size_t)e * FF * DM, FF, DM, W_MDN + (size_t)e * DM * FF, MapId{}, cum, gw, NGW, scr, lane);
        }
        for (int i = bid * 512 + tid; i < DEPTH * (ZW - ZREAL) * DM / 8; i += G * 512) {
            const int l = i / ((ZW - ZREAL) * DM / 8), r = i - l * ((ZW - ZREAL) * DM / 8);
            *(GAS v4u*)(W_WIN + (size_t)l * ZW * DM + (size_t)ZREAL * DM + (size_t)r * 8) = (v4u){0u, 0u, 0u, 0u};
        }
        for (int i = bid * 512 + tid; i < T * 32; i += G * 512) {
            const int t = i >> 5, k = i & 31;
            const float inv = 1.0f / powf(10000.0f, (float)(2 * k) / 64.0f);
            const float ang = (float)I_positions[t] * inv;
            const double rev = (double)ang * 0.15915494309189533577;
            const float fr = (float)(rev - floor(rev));
            W_COS[i] = __builtin_amdgcn_cosf(fr); W_SIN[i] = __builtin_amdgcn_sinf(fr);
        }
        for (int i = bid * 512 + tid; i < 1024; i += G * 512) {
            const float a0 = I_lbl[i], a1 = I_lbl[1024 + i], mx = fmaxf(a0, a1), e0 = expf(a0 - mx), e1 = expf(a1 - mx), p0 = e0 / (e0 + e1), p1 = e1 / (e0 + e1);
            W_LB[i] = p0 - p0; W_LB[1024 + i] = (p0 + p1) - p0;
        }
        for (int i = bid * 512 + tid; i < DEPTH * T * PLE / 4; i += G * 512) {
            const f32x4 v = ((const GAS f32x4*)I_pin)[i];
            typedef unsigned u32x2v __attribute__((ext_vector_type(2)));
            u32x2v w; w.x = pk2(v.x, v.y); w.y = pk2(v.z, v.w); ((GAS u32x2v*)W_PB)[i] = w;
        }
        for (int m = gw; m < T; m += NGW) {
            f32x4 v[8], g[8]; row_load(I_x + (size_t)m * DM, lane, v); row_load(I_snorm, lane, g);
            const float rstd = rsqrtf(row_ss(v) * (1.0f / DM) + EPS);
#pragma unroll
            for (int j = 0; j < 8; ++j) v[j] = v[j] * rstd * g[j];
            row_store_bf16(W_XN + (size_t)m * DM, lane, v);
        }
    }
    SEAM(0);

    layer_phases<0>(lo, hi, bar, lds, wave, G, bid);
    layer_phases<1>(lo, hi, bar, lds, wave, G, bid);
#undef PH
#undef SEAM
}

static bool phase_live(int ph) {
    if (ph == 0) return true;
    const int l = (ph - 1) / NPL, k = (ph - 1) % NPL;
    if (k >= 11 && k <= 29) return false;
    if ((l & 1) == 0) return !(k >= 8 && k <= 10);
    return !(k == 6 || k == 7);
}
extern "C" void kernel_launch(void* const* d_in, const int* in_sizes, int n_in, void* d_out, int out_size, void* d_ws, size_t ws_size, hipStream_t stream) {
    static int grid = 0;
    if (grid == 0) {
        if (n_in != 20 || out_size != T * DM || ws_size < WS_END) { fprintf(stderr, "kernel_launch: shape/workspace mismatch (n_in %d out %d ws %zu need %zu)\n", n_in, out_size, ws_size, (size_t)WS_END); grid = -1; return; }
        int dev = 0, cus = 0;
        if (hipGetDevice(&dev) != hipSuccess || hipDeviceGetAttribute(&cus, hipDeviceAttributeMultiprocessorCount, dev) != hipSuccess) { grid = -1; return; }
        if (hipFuncSetAttribute((const void*)mk_fwd, hipFuncAttributeMaxDynamicSharedMemorySize, LDS_BYTES) != hipSuccess) { fprintf(stderr, "kernel_launch: hipFuncSetAttribute failed\n"); grid = -1; return; }
        (void)hipGetLastError();
        grid = cus;
    }
    if (grid < 0) return;
    (void)in_sizes;
    if (hipMemsetAsync((char*)d_ws + WS_CTL, 0, CTL_ZERO_BYTES, stream) != hipSuccess) return;
    Args a{};
    for (int i = 0; i < 20; ++i) a.in[i] = (const float*)d_in[i];
    a.out = (float*)d_out; a.ws = (unsigned char*)d_ws;
#if MK_ONE_LAUNCH
    a.ph_lo = 0; a.ph_hi = NPH;
    hipLaunchKernelGGL(mk_fwd, dim3(grid), dim3(NWAVES * 64), LDS_BYTES, stream, a);
#else
    for (int ph = 0; ph < NPH; ++ph) {
        if (!phase_live(ph)) continue;
        a.ph_lo = ph; a.ph_hi = ph + 1;
        hipLaunchKernelGGL(mk_fwd, dim3(grid), dim3(NWAVES * 64), LDS_BYTES, stream, a);
    }
#endif
}
```
